# Optimizing an MI355X kernel written in HIP

```python
import math
import jax, jax.numpy as jnp
from jax import lax
import numpy as np

D_MODEL = 1024
BATCH = 2
SEQ = 16384
DEPTH = 2
DEC_BATCH = 8
DEC_SEQ = 2048
PAST_LEN = 128

N_META = 16
SSM_WIDTH = 512
SSM_GROUP = 16
SSM_GROUPS = SSM_WIDTH // SSM_GROUP
SSM_STATE = 64
DT_MIN = 1e-3
DT_MAX = 1e-1
N_HEADS = 8
QK_NOPE = 128
QK_ROPE = 64
V_HEAD = 128
Q_LORA = 384
KV_LORA = 256
ROPE_THETA = 10000.0
Q_BLOCK = 128
D_FF = -(-8 * D_MODEL // (3 * 256)) * 256
EPS = 1e-6
IN_COLS = SSM_WIDTH + Q_LORA + KV_LORA + QK_ROPE + 2 * D_MODEL

kernel_name = "hybrid_s5_mla_gated_encoder"


def rmsnorm(x, g):
    xf = x.astype(jnp.float32)
    y = xf * lax.rsqrt(jnp.mean(xf * xf, axis=-1, keepdims=True) + EPS)
    return (y * g.astype(jnp.float32)).astype(x.dtype)


def rope_tables(L, dtype):
    inv = 1.0 / (ROPE_THETA ** (jnp.arange(0, QK_ROPE, 2, dtype=jnp.float32) / QK_ROPE))
    ang = jnp.arange(L, dtype=jnp.float32)[:, None] * inv[None, :]
    return jnp.cos(ang).astype(dtype), jnp.sin(ang).astype(dtype)


def apply_rope(x, cos, sin):
    x1, x2 = jnp.split(x, 2, axis=-1)
    return jnp.concatenate([x1 * cos - x2 * sin, x1 * sin + x2 * cos], axis=-1)


def _ssm_combine(e1, e2):
    a1r, a1i, b1r, b1i = e1
    a2r, a2i, b2r, b2i = e2
    return (a2r * a1r - a2i * a1i,
            a2r * a1i + a2i * a1r,
            a2r * b1r - a2i * b1i + b2r,
            a2r * b1i + a2i * b1r + b2i)


def s5_direction(u, lam_re, lam_im, log_dt, b_re, b_im, c_re, c_im, reverse):
    lam_re = lam_re.astype(jnp.float32)
    lam_im = lam_im.astype(jnp.float32)
    dt = jnp.exp(log_dt.astype(jnp.float32))[:, None]
    mag = jnp.exp(lam_re * dt)
    ar = mag * jnp.cos(lam_im * dt)
    ai = mag * jnp.sin(lam_im * dt)
    den = lam_re * lam_re + lam_im * lam_im
    nr = ar - 1.0
    sr = (nr * lam_re + ai * lam_im) / den
    si = (ai * lam_re - nr * lam_im) / den
    b_re = b_re.astype(jnp.float32)
    b_im = b_im.astype(jnp.float32)
    bbr = sr[..., None] * b_re - si[..., None] * b_im
    bbi = sr[..., None] * b_im + si[..., None] * b_re
    bur = jnp.einsum('blgh,gph->blgp', u, bbr)
    bui = jnp.einsum('blgh,gph->blgp', u, bbi)
    shp = (1, u.shape[1]) + ar.shape
    a_r = jnp.broadcast_to(ar, shp)
    a_i = jnp.broadcast_to(ai, shp)
    _, _, xr, xi = lax.associative_scan(_ssm_combine, (a_r, a_i, bur, bui), reverse=reverse, axis=1)
    return (jnp.einsum('blgp,ghp->blgh', xr, c_re.astype(jnp.float32))
            - jnp.einsum('blgp,ghp->blgh', xi, c_im.astype(jnp.float32)))


def mla_attention(qn, qr, kn, kr, v):
    B, L, H, _ = qn.shape
    scale = 1.0 / math.sqrt(QK_NOPE + QK_ROPE)

    def block(qb):
        qnb, qrb = qb
        s = (jnp.einsum('bqhd,bkhd->bhqk', qnb, kn)
             + jnp.einsum('bqhd,bkd->bhqk', qrb, kr))
        p = jax.nn.softmax(s.astype(jnp.float32) * scale, axis=-1).astype(v.dtype)
        return jnp.einsum('bhqk,bkhd->bqhd', p, v)

    o_meta = block((qn[:, :N_META], qr[:, :N_META]))
    S = L - N_META
    nb = S // Q_BLOCK

    def to_blocks(t):
        return jnp.moveaxis(t[:, N_META:].reshape((B, nb, Q_BLOCK) + t.shape[2:]), 1, 0)

    o_real = lax.map(block, (to_blocks(qn), to_blocks(qr)))
    o_real = jnp.moveaxis(o_real, 0, 1).reshape(B, S, H, V_HEAD)
    return jnp.concatenate([o_meta, o_real], axis=1)


def mixer(h, cos, sin, w_in, lam_re, lam_im, log_dt, b_re, b_im, c_re, c_im, d_skip,
          w_glu, b_glu, w_ssm_out, g_cq, w_uq, g_ckv, w_ukv, w_attn_out, w_mix_out):
    B, L, _ = h.shape
    proj = h @ w_in
    o1 = SSM_WIDTH
    o2 = o1 + Q_LORA
    o3 = o2 + KV_LORA
    o4 = o3 + QK_ROPE
    o5 = o4 + D_MODEL
    u, cq, ckv, kr, ga, gb = (proj[..., :o1], proj[..., o1:o2], proj[..., o2:o3],
                              proj[..., o3:o4], proj[..., o4:o5], proj[..., o5:])
    uf = u.astype(jnp.float32).reshape(B, L, SSM_GROUPS, SSM_GROUP)
    y = (s5_direction(uf, lam_re[0], lam_im[0], log_dt[0], b_re[0], b_im[0], c_re[0], c_im[0], False)
         + s5_direction(uf, lam_re[1], lam_im[1], log_dt[1], b_re[1], b_im[1], c_re[1], c_im[1], True))
    y = (y.reshape(B, L, SSM_WIDTH) + d_skip.astype(jnp.float32) * uf.reshape(B, L, SSM_WIDTH)).astype(h.dtype)
    z = jax.nn.gelu(y)
    z = z * jax.nn.sigmoid(z @ w_glu + b_glu)
    a_out = z @ w_ssm_out
    q = (rmsnorm(cq, g_cq) @ w_uq).reshape(B, L, N_HEADS, QK_NOPE + QK_ROPE)
    qn = q[..., :QK_NOPE]
    qr = apply_rope(q[..., QK_NOPE:], cos[:, None], sin[:, None])
    kv = (rmsnorm(ckv, g_ckv) @ w_ukv).reshape(B, L, N_HEADS, QK_NOPE + V_HEAD)
    kn = kv[..., :QK_NOPE]
    v = kv[..., QK_NOPE:]
    krr = apply_rope(kr, cos, sin)
    o = mla_attention(qn, qr, kn, krr, v).reshape(B, L, N_HEADS * V_HEAD)
    b_out = o @ w_attn_out
    merged = jax.nn.sigmoid(ga) * a_out + jax.nn.sigmoid(gb) * b_out
    return merged @ w_mix_out


def swiglu(h, w_gate, w_up, w_down):
    return (jax.nn.silu(h @ w_gate) * (h @ w_up)) @ w_down


def encoder_forward(x, meta_tokens, norm_mix, w_in, ssm_lam_re, ssm_lam_im, ssm_log_dt,
                    ssm_b_re, ssm_b_im, ssm_c_re, ssm_c_im, ssm_d, w_glu, b_glu, w_ssm_out,
                    norm_cq, w_uq, norm_ckv, w_ukv, w_attn_out, w_mix_out, norm_ffn,
                    w_ffn_gate, w_ffn_up, w_ffn_down, norm_final):
    B = x.shape[0]
    meta = jnp.broadcast_to(meta_tokens.astype(x.dtype)[None], (B, N_META, D_MODEL))
    h = jnp.concatenate([meta, x], axis=1)
    cos, sin = rope_tables(h.shape[1], x.dtype)
    for i in range(DEPTH):
        h = h + mixer(rmsnorm(h, norm_mix[i]), cos, sin, w_in[i], ssm_lam_re[i], ssm_lam_im[i],
                      ssm_log_dt[i], ssm_b_re[i], ssm_b_im[i], ssm_c_re[i], ssm_c_im[i], ssm_d[i],
                      w_glu[i], b_glu[i], w_ssm_out[i], norm_cq[i], w_uq[i], norm_ckv[i], w_ukv[i],
                      w_attn_out[i], w_mix_out[i])
        h = h + swiglu(rmsnorm(h, norm_ffn[i]), w_ffn_gate[i], w_ffn_up[i], w_ffn_down[i])
    return rmsnorm(h, norm_final)[:, N_META:]


def setup_inputs(seed: int = 0) -> dict:
    key = jax.random.key(seed)
    ks = jax.random.split(key, 32)
    f32 = jnp.float32

    def nrm(k, shape, scale):
        return jax.random.normal(k, shape, f32) * scale

    def gain(k, shape):
        return 1.0 + 0.01 * jax.random.normal(k, shape, f32)

    P, G, Hg = SSM_STATE, SSM_GROUPS, SSM_GROUP
    lam_re = -0.5 + 0.01 * jax.random.normal(ks[4], (DEPTH, 2, G, P), f32)
    lam_im = (math.pi * jnp.arange(P, dtype=f32))[None, None, None, :] + 0.01 * jax.random.normal(ks[5], (DEPTH, 2, G, P), f32)
    log_dt = jax.random.uniform(ks[6], (DEPTH, 2, G), f32, minval=math.log(DT_MIN), maxval=math.log(DT_MAX))
    return {
        "x_prompt": jax.random.normal(ks[0], (BATCH, SEQ, D_MODEL), f32),
        "x_sample": jax.random.normal(ks[1], (DEC_BATCH, DEC_SEQ, D_MODEL), f32),
        "meta_tokens": nrm(ks[2], (N_META, D_MODEL), 1.0),
        "norm_mix": gain(ks[3], (DEPTH, D_MODEL)),
        "w_in": nrm(ks[7], (DEPTH, D_MODEL, IN_COLS), D_MODEL ** -0.5),
        "ssm_lam_re": lam_re,
        "ssm_lam_im": lam_im,
        "ssm_log_dt": log_dt,
        "ssm_b_re": nrm(ks[8], (DEPTH, 2, G, P, Hg), (2.0 * Hg) ** -0.5),
        "ssm_b_im": nrm(ks[9], (DEPTH, 2, G, P, Hg), (2.0 * Hg) ** -0.5),
        "ssm_c_re": nrm(ks[10], (DEPTH, 2, G, Hg, P), P ** -0.5),
        "ssm_c_im": nrm(ks[11], (DEPTH, 2, G, Hg, P), P ** -0.5),
        "ssm_d": nrm(ks[12], (DEPTH, SSM_WIDTH), 1.0),
        "w_glu": nrm(ks[13], (DEPTH, SSM_WIDTH, SSM_WIDTH), SSM_WIDTH ** -0.5),
        "b_glu": nrm(ks[14], (DEPTH, SSM_WIDTH), 0.01),
        "w_ssm_out": nrm(ks[15], (DEPTH, SSM_WIDTH, D_MODEL), SSM_WIDTH ** -0.5),
        "norm_cq": gain(ks[16], (DEPTH, Q_LORA)),
        "w_uq": nrm(ks[17], (DEPTH, Q_LORA, N_HEADS * (QK_NOPE + QK_ROPE)), Q_LORA ** -0.5),
        "norm_ckv": gain(ks[18], (DEPTH, KV_LORA)),
        "w_ukv": nrm(ks[19], (DEPTH, KV_LORA, N_HEADS * (QK_NOPE + V_HEAD)), KV_LORA ** -0.5),
        "w_attn_out": nrm(ks[20], (DEPTH, N_HEADS * V_HEAD, D_MODEL), (N_HEADS * V_HEAD) ** -0.5),
        "w_mix_out": nrm(ks[21], (DEPTH, D_MODEL, D_MODEL), D_MODEL ** -0.5),
        "norm_ffn": gain(ks[22], (DEPTH, D_MODEL)),
        "w_ffn_gate": nrm(ks[23], (DEPTH, D_MODEL, D_FF), D_MODEL ** -0.5),
        "w_ffn_up": nrm(ks[24], (DEPTH, D_MODEL, D_FF), D_MODEL ** -0.5),
        "w_ffn_down": nrm(ks[25], (DEPTH, D_FF, D_MODEL), D_FF ** -0.5),
        "norm_final": gain(ks[26], (D_MODEL,)),
    }


def reference(x_prompt, x_sample, meta_tokens, norm_mix, w_in, ssm_lam_re, ssm_lam_im, ssm_log_dt,
              ssm_b_re, ssm_b_im, ssm_c_re, ssm_c_im, ssm_d, w_glu, b_glu, w_ssm_out,
              norm_cq, w_uq, norm_ckv, w_ukv, w_attn_out, w_mix_out, norm_ffn,
              w_ffn_gate, w_ffn_up, w_ffn_down, norm_final):
    y_prompt = encoder_forward(x_prompt, meta_tokens, norm_mix, w_in, ssm_lam_re, ssm_lam_im, ssm_log_dt,
                               ssm_b_re, ssm_b_im, ssm_c_re, ssm_c_im, ssm_d, w_glu, b_glu, w_ssm_out,
                               norm_cq, w_uq, norm_ckv, w_ukv, w_attn_out, w_mix_out, norm_ffn,
                               w_ffn_gate, w_ffn_up, w_ffn_down, norm_final)
    y_sample = encoder_forward(x_sample, meta_tokens, norm_mix, w_in, ssm_lam_re, ssm_lam_im, ssm_log_dt,
                               ssm_b_re, ssm_b_im, ssm_c_re, ssm_c_im, ssm_d, w_glu, b_glu, w_ssm_out,
                               norm_cq, w_uq, norm_ckv, w_ukv, w_attn_out, w_mix_out, norm_ffn,
                               w_ffn_gate, w_ffn_up, w_ffn_down, norm_final)
    return (y_prompt, y_sample)
```

```cpp
#include <hip/hip_runtime.h>
#include <hip/hip_cooperative_groups.h>
#include <cstdio>
#include <cstdint>
#include <cmath>
namespace cg = cooperative_groups;

typedef unsigned short bf16_t;
typedef short bf16x8 __attribute__((ext_vector_type(8)));
typedef short s16x4 __attribute__((ext_vector_type(4)));
typedef float f32x16 __attribute__((ext_vector_type(16)));
typedef float f32x4 __attribute__((ext_vector_type(4)));
typedef unsigned u32x4 __attribute__((ext_vector_type(4)));
typedef unsigned u32x2 __attribute__((ext_vector_type(2)));
#define DEVI __device__ __forceinline__
#define SBAR() __builtin_amdgcn_sched_barrier(0)

constexpr int NREAL = 49152, META0 = 49152, MPAD = 49920, NTILE_M = 195;
constexpr int NCHUNK = 1560, NCHUNK_PAD = 1792;
constexpr int QG_ROWS = 16896;
constexpr int LDS_BYTES = 150528;

struct Params {
  const float* x_prompt; const float* x_sample; const float* meta; const float* norm_mix; const float* w_in;
  const float* lam_re; const float* lam_im; const float* log_dt; const float* b_re; const float* b_im; const float* c_re; const float* c_im;
  const float* ssm_d; const float* w_glu; const float* b_glu; const float* w_ssm_out; const float* norm_cq; const float* w_uq;
  const float* norm_ckv; const float* w_ukv; const float* w_attn_out; const float* w_mix_out; const float* norm_ffn;
  const float* w_ffn_gate; const float* w_ffn_up; const float* w_ffn_down; const float* norm_final;
  float* out; char* ws;
  float inv[32];
};

constexpr size_t al(size_t x) { return (x + 255) & ~size_t(255); }
constexpr size_t O_WIN = 0;
constexpr size_t O_WG = O_WIN + al((size_t)1280 * 1024 * 2);
constexpr size_t O_WGLU = O_WG + al((size_t)2048 * 1024 * 2);
constexpr size_t O_WSSM = O_WGLU + al((size_t)512 * 512 * 2);
constexpr size_t O_WUQ = O_WSSM + al((size_t)1024 * 512 * 2);
constexpr size_t O_WUKV = O_WUQ + al((size_t)1536 * 384 * 2);
constexpr size_t O_WATTN = O_WUKV + al((size_t)2048 * 256 * 2);
constexpr size_t O_WMIX = O_WATTN + al((size_t)1024 * 1024 * 2);
constexpr size_t O_WGU = O_WMIX + al((size_t)1024 * 1024 * 2);
constexpr int LDX = 1088;
constexpr size_t O_WD = O_WGU + al((size_t)5632 * LDX * 2);
constexpr size_t O_APOW = O_WD + al((size_t)1024 * 2816 * 2);
constexpr size_t O_BBAR = O_APOW + al((size_t)2 * 32 * 33 * 64 * 8);
constexpr size_t O_KFB = O_BBAR + al((size_t)2 * 32 * 64 * 16 * 8);
constexpr size_t O_W1T = O_KFB + al((size_t)2 * 32 * 32 * 256 * 4);
constexpr size_t O_W3T = O_W1T + al((size_t)32 * 256 * 512 * 2);
constexpr size_t O_ROPE = O_W3T + al((size_t)32 * 512 * 768 * 2);
constexpr size_t O_HMETA = O_ROPE + al((size_t)16400 * 32 * 8);
constexpr size_t O_BAR = O_HMETA + al((size_t)768 * 1024 * 4);
constexpr size_t O_RSTD = O_BAR + al((size_t)4096 * 4);
constexpr size_t O_ARENA = O_RSTD + al((size_t)49920 * 2 * 4);
constexpr size_t A_Z2 = 0;
constexpr size_t A_CARRY = 0;
constexpr size_t A_O = 51118080;
constexpr size_t A_XN1 = A_O;
constexpr size_t A_QG = 153354240;
constexpr size_t A_U = A_QG;
constexpr size_t A_KVG = 205258752;
constexpr size_t A_SLOC = A_KVG;
constexpr size_t A_Z1 = A_KVG;
constexpr size_t A_CQ = 274464768;
constexpr size_t A_CKV = 312803328;
constexpr size_t A_KR = 338362368;
constexpr size_t A_XN2 = A_QG;
constexpr size_t A_MERGED = 255590400;
constexpr size_t A_XN3 = 0;
constexpr size_t A_HID = 108625920;
constexpr size_t ARENA_SIZE = 389775360;
constexpr size_t WS_NEED = O_ARENA + ARENA_SIZE;

DEVI int otid() { int t = __builtin_amdgcn_workitem_id_x(); asm volatile("" : "+v"(t)); return t; }
DEVI bf16_t f2bf(float f) { unsigned u = __float_as_uint(f); u += 0x7fffu + ((u >> 16) & 1u); return (bf16_t)(u >> 16); }
DEVI float bf2f(bf16_t b) { return __uint_as_float(((unsigned)b) << 16); }
typedef __bf16 bf16x2_t __attribute__((ext_vector_type(2)));
DEVI unsigned cvtpk(float lo, float hi) { bf16x2_t v; v[0] = (__bf16)lo; v[1] = (__bf16)hi; return __builtin_bit_cast(unsigned, v); }
DEVI int crow(int r, int hi) { return (r & 3) + 8 * (r >> 2) + 4 * hi; }
DEVI float sigmoidf_(float x) { return __builtin_amdgcn_rcpf(1.f + __expf(-x)); }
DEVI int pos_of_row(int m) {
  if (m < 32768) return (m & 16383) + 16;
  if (m < NREAL) return ((m - 32768) & 2047) + 16;
  int lr = (m - META0) & 63; return lr >= 48 ? lr - 48 : 0;
}
DEVI f32x4 unpack4(u32x2 w) { f32x4 v; v[0] = __uint_as_float(w.x << 16); v[1] = __uint_as_float(w.x & 0xffff0000u); v[2] = __uint_as_float(w.y << 16); v[3] = __uint_as_float(w.y & 0xffff0000u); return v; }
DEVI bool is_pad_lr(int lr) { return lr >= 640 || (lr & 63) < 48; }
template <int MI> DEVI void zero_acc(f32x16 (&acc)[MI][2]) {
#pragma unroll
  for (int mi = 0; mi < MI; ++mi)
#pragma unroll
    for (int ni = 0; ni < 2; ++ni)
#pragma unroll
      for (int r = 0; r < 16; ++r) acc[mi][ni][r] = 0.f;
}
#define FOR_MN(mi, ni) _Pragma("unroll") for (int mi = 0; mi < MIV; ++mi) _Pragma("unroll") for (int ni = 0; ni < 2; ++ni)
#define FOR_R(r) _Pragma("unroll") for (int r = 0; r < 16; ++r)
#define FOR_ACC(mi, ni, r) _Pragma("unroll") for (int mi = 0; mi < MIV; ++mi) _Pragma("unroll") for (int ni = 0; ni < 2; ++ni) _Pragma("unroll") for (int r = 0; r < 16; ++r)

template <int MI> struct GStage { u32x4 ra0[MI], rb0[4], ra1[MI], rb1[4]; };
#define GEMM_ADDR()                                                                                                                 \
  const int tid = otid(), lane = tid & 63, wid = tid >> 6, r32 = lane & 31, hi = lane >> 5;                                        \
  const int wm = wid >> 2, wn = wid & 3;                                                                                            \
  const int lrow = tid >> 3, lslot = tid & 7;                                                                                       \
  unsigned aoff[MI];                                                                                                                \
  _Pragma("unroll") for (int i = 0; i < MI; ++i) { int r = lrow + 64 * i; r = r < arows ? r : arows - 1; aoff[i] = (unsigned)(r * lda) * 2u; }  \
  const unsigned boff = (unsigned)(lrow * ldb + lslot * 8) * 2u;                                                                    \
  const int pmask = (1 << pl) - 1;                                                                                                  \
  const int nk = K >> 6;
#define GLOAD(RA, RB, kt_) do { const int k_ = (kt_) * 64 + lslot * 8; const unsigned ko_ = (unsigned)(((k_ >> pl) * ps) + (k_ & pmask)) * 2u;  \
    _Pragma("unroll") for (int i = 0; i < MI; ++i) RA[i] = *(const u32x4*)((const char*)A + (aoff[i] + ko_));                       \
    _Pragma("unroll") for (int i = 0; i < 4; ++i) RB[i] = *(const u32x4*)((const char*)B + (boff + (unsigned)(64 * i * ldb + (kt_) * 64) * 2u)); } while (0)

template <int MI, int PF = 2>
DEVI void gemm_prefetch(GStage<MI>& st, const bf16_t* __restrict__ A, int lda, int arows, int pl, int ps,
                        const bf16_t* __restrict__ B, int ldb, int K) {
  GEMM_ADDR();
  (void)hi; (void)wm; (void)wn; (void)r32;
  GLOAD(st.ra0, st.rb0, 0);
  if constexpr (PF == 2) { if (nk > 1) GLOAD(st.ra1, st.rb1, 1); }
}

template <int MI, int PF = 2, int KSBT = 0>
DEVI void gemm_main(f32x16 (&acc)[MI][2], GStage<MI>& st, const bf16_t* __restrict__ A, int lda, int arows, int pl, int ps,
                    const bf16_t* __restrict__ B, int ldb, int K, char* lds) {
  GEMM_ADDR();
  const int wofs = lrow * 128 + ((lslot ^ ((lrow >> 1) & 7)) << 4);
#define LWRITE(b_, RA, RB) do { char* As_ = lds + (b_) * 32768 + wofs; char* Bs_ = lds + 65536 + (b_) * 32768 + wofs;            \
    _Pragma("unroll") for (int i = 0; i < MI; ++i) *(u32x4*)(As_ + i * 8192) = RA[i];                                              \
    _Pragma("unroll") for (int i = 0; i < 4; ++i) *(u32x4*)(Bs_ + i * 8192) = RB[i]; } while (0)
  const int swz = (r32 >> 1) & 7;
  const int abase = (wm * (32 * MI) + r32) * 128, bbase = 65536 + (wn * 64 + r32) * 128;
  constexpr int KSB = KSBT ? KSBT : (MI == 2 ? 2 : 1);
  constexpr int MHF = MI == 4 ? 2 : MI;
#define COMPUTE(b_) do { const char* Ab_ = lds + (b_) * 32768 + abase; const char* Bb_ = lds + (b_) * 32768 + bbase;              \
    _Pragma("unroll") for (int kb = 0; kb < 4; kb += KSB) _Pragma("unroll") for (int mh = 0; mh < MI; mh += MHF) {                 \
      bf16x8 fa_[KSB][MHF], fb_[KSB][2];                                                                                           \
      _Pragma("unroll") for (int k2 = 0; k2 < KSB; ++k2) { const int so = (((kb + k2) * 2 + hi) ^ swz) << 4;                       \
        _Pragma("unroll") for (int mi = 0; mi < MHF; ++mi) fa_[k2][mi] = *(const bf16x8*)(Ab_ + (mh + mi) * 4096 + so);            \
        _Pragma("unroll") for (int ni = 0; ni < 2; ++ni) fb_[k2][ni] = *(const bf16x8*)(Bb_ + ni * 4096 + so); }                   \
      SBAR();                                                                                                                      \
      _Pragma("unroll") for (int k2 = 0; k2 < KSB; ++k2) _Pragma("unroll") for (int mi = 0; mi < MHF; ++mi)                        \
        _Pragma("unroll") for (int ni = 0; ni < 2; ++ni)                                                                           \
          acc[mh + mi][ni] = __builtin_amdgcn_mfma_f32_32x32x16_bf16(fa_[k2][mi], fb_[k2][ni], acc[mh + mi][ni], 0, 0, 0);         \
      SBAR(); } } while (0)
  if constexpr (PF == 2) {
    __syncthreads(); LWRITE(0, st.ra0, st.rb0); __syncthreads();
#pragma unroll 1
    for (int kt = 0; kt < nk; kt += 2) {
      if (kt + 2 < nk) GLOAD(st.ra0, st.rb0, kt + 2);
      COMPUTE(0);
      if (kt + 1 < nk) LWRITE(1, st.ra1, st.rb1);
      __syncthreads();
      if (kt + 1 >= nk) break;
      if (kt + 3 < nk) GLOAD(st.ra1, st.rb1, kt + 3);
      COMPUTE(1);
      if (kt + 2 < nk) LWRITE(0, st.ra0, st.rb0);
      __syncthreads();
    }
  } else {
    __syncthreads(); LWRITE(0, st.ra0, st.rb0); __syncthreads();
#pragma unroll 1
    for (int kt = 0; kt < nk; ++kt) {
      const int b = kt & 1;
      if (kt + 1 < nk) GLOAD(st.ra0, st.rb0, kt + 1);
      COMPUTE(b);
      if (kt + 1 < nk) LWRITE(b ^ 1, st.ra0, st.rb0);
      __syncthreads();
    }
  }
#undef LWRITE
#undef COMPUTE
}

template <int MI, int PF = 2>
DEVI void gemm_acc(f32x16 (&acc)[MI][2], const bf16_t* __restrict__ A, int lda, int arows, int pl, int ps,
                   const bf16_t* __restrict__ B, int ldb, int K, char* lds) {
  GStage<MI> st;
  gemm_prefetch<MI, PF>(st, A, lda, arows, pl, ps, B, ldb, K);
  gemm_main<MI, PF, (MI == 2 ? 4 : 0)>(acc, st, A, lda, arows, pl, ps, B, ldb, K, lds);
}

DEVI bool unit_xcd(int i, int nM, int nN, int& mt, int& nt) {
  const int x = blockIdx.x & 7, lb = blockIdx.x >> 3, nb = gridDim.x >> 3;
  const int m0 = (x * nM) >> 3, m1 = ((x + 1) * nM) >> 3;
  const int li = lb + nb * i;
  if (li >= (m1 - m0) * nN) return false;
  mt = m0 + li / nN; nt = li % nN; return true;
}

DEVI bool unit_xcd_cb(int i, int nM, int nN, int CB, int& mt, int& nt) {
  const int x = blockIdx.x & 7, lb = blockIdx.x >> 3, nb = gridDim.x >> 3;
  const int m0 = (x * nM) >> 3, m1 = ((x + 1) * nM) >> 3, Mx = m1 - m0;
  const int li = lb + nb * i;
  const int nbk = nN / CB, rem = nN - nbk * CB, full = nbk * CB * Mx;
  if (li < full) { const int b = li / (CB * Mx), r = li - b * (CB * Mx); mt = m0 + r / CB; nt = b * CB + r % CB; return true; }
  const int l2 = li - full;
  if (rem == 0 || l2 >= rem * Mx) return false;
  mt = m0 + l2 / rem; nt = nbk * CB + l2 % rem; return true;
}

DEVI void conv_job(const float* __restrict__ src, int K, int N, int ncol0, int ncols, bf16_t* __restrict__ dst, int mode,
                   const float* __restrict__ kscale, int wgid, int nwaves, char* ldsw, int& joff, int dld = 0) {
  if (dld == 0) dld = K;
  const int ntn = ncols >> 6, ntk = K >> 6, lane = otid() & 63;
  bf16_t* t = (bf16_t*)ldsw;
  int start = wgid - (joff % nwaves); if (start < 0) start += nwaves;
  for (int ti = start; ti < ntn * ntk; ti += nwaves) {
    const int tn = ti % ntn, tk = ti / ntn, n0 = tn * 64, k0 = tk * 64;
#pragma unroll 16
    for (int i = 0; i < 64; ++i) {
      float v = src[(long)(k0 + i) * N + ncol0 + n0 + lane];
      if (kscale) v *= kscale[k0 + i];
      t[lane * 66 + i] = f2bf(v);
    }
    __builtin_amdgcn_wave_barrier();
    asm volatile("s_waitcnt lgkmcnt(0)" ::: "memory");
    for (int it = 0; it < 32; ++it) {
      const int row = it * 2 + (lane >> 5), c2 = (lane & 31) * 2;
      const unsigned v = *(const unsigned*)&t[row * 66 + c2];
      const int n = n0 + row;
      const int orow = mode == 0 ? n : ((n >> 5) * 64 + (n & 31) + (mode == 2 ? 32 : 0));
      *(unsigned*)&dst[(long)orow * dld + k0 + c2] = v;
    }
    __builtin_amdgcn_wave_barrier();
    asm volatile("s_waitcnt lgkmcnt(0)" ::: "memory");
  }
  joff += ntn * ntk;
}

DEVI void phase_convert(const Params& p, int L, char* lds) {
  char* ws = p.ws;
  const int wgid = blockIdx.x * 8 + (otid() >> 6), nwaves = gridDim.x * 8;
  char* ldsw = lds + (otid() >> 6) * 8448;
  int joff = 0;
  conv_job(p.w_in + (size_t)L * 1024 * 3264, 1024, 3264, 0, 1216, (bf16_t*)(ws + O_WIN), 0, nullptr, wgid, nwaves, ldsw, joff);
  conv_job(p.w_in + (size_t)L * 1024 * 3264, 1024, 3264, 1216, 2048, (bf16_t*)(ws + O_WG), 0, nullptr, wgid, nwaves, ldsw, joff);
  conv_job(p.w_glu + (size_t)L * 512 * 512, 512, 512, 0, 512, (bf16_t*)(ws + O_WGLU), 0, nullptr, wgid, nwaves, ldsw, joff);
  conv_job(p.w_ssm_out + (size_t)L * 512 * 1024, 512, 1024, 0, 1024, (bf16_t*)(ws + O_WSSM), 0, nullptr, wgid, nwaves, ldsw, joff);
  conv_job(p.w_uq + (size_t)L * 384 * 1536, 384, 1536, 0, 1536, (bf16_t*)(ws + O_WUQ), 0, p.norm_cq + L * 384, wgid, nwaves, ldsw, joff);
  conv_job(p.w_ukv + (size_t)L * 256 * 2048, 256, 2048, 0, 2048, (bf16_t*)(ws + O_WUKV), 0, p.norm_ckv + L * 256, wgid, nwaves, ldsw, joff);
  conv_job(p.w_attn_out + (size_t)L * 1024 * 1024, 1024, 1024, 0, 1024, (bf16_t*)(ws + O_WATTN), 0, nullptr, wgid, nwaves, ldsw, joff);
  conv_job(p.w_mix_out + (size_t)L * 1024 * 1024, 1024, 1024, 0, 1024, (bf16_t*)(ws + O_WMIX), 0, nullptr, wgid, nwaves, ldsw, joff);
  conv_job(p.w_ffn_gate + (size_t)L * 1024 * 2816, 1024, 2816, 0, 2816, (bf16_t*)(ws + O_WGU), 1, nullptr, wgid, nwaves, ldsw, joff, LDX);
  conv_job(p.w_ffn_up + (size_t)L * 1024 * 2816, 1024, 2816, 0, 2816, (bf16_t*)(ws + O_WGU), 2, nullptr, wgid, nwaves, ldsw, joff, LDX);
  conv_job(p.w_ffn_down + (size_t)L * 2816 * 1024, 2816, 1024, 0, 1024, (bf16_t*)(ws + O_WD), 0, nullptr, wgid, nwaves, ldsw, joff);
  unsigned* z = (unsigned*)(ws + O_WIN + (size_t)1216 * 1024 * 2);
  const int zt = otid();
#pragma unroll 1
  for (int b = blockIdx.x; b < 64; b += gridDim.x) z[b * 512 + zt] = 0u;
}

DEVI void sincos_rev(double ang, float& c, float& s) {
  double t = ang * 0.15915494309189535; t -= rint(t);
  const float tf = (float)t;
  c = __builtin_amdgcn_cosf(tf); s = __builtin_amdgcn_sinf(tf);
}

DEVI void phase_s5prep1(const Params& p, int L) {
  char* ws = p.ws;
  float2* Apow = (float2*)(ws + O_APOW); float2* Bbar = (float2*)(ws + O_BBAR);
  const int gtid = blockIdx.x * 512 + otid(), nthr = gridDim.x * 512;
  for (int idx = gtid; idx < 4096; idx += nthr) {
    const int pp = idx & 63, g = (idx >> 6) & 31, dir = idx >> 11;
    const int pg = (L * 2 + dir) * 32 + g;
    const float lr = p.lam_re[pg * 64 + pp], li = p.lam_im[pg * 64 + pp];
    const float dt = expf(p.log_dt[pg]);
    float ar = 1.f, ai = 0.f;
    for (int d = 0; d <= 32; ++d) {
      float c, s; sincos_rev((double)li * (double)dt * (double)d, c, s);
      const float mag = expf(lr * dt * (float)d);
      Apow[((dir * 32 + g) * 33 + d) * 64 + pp] = make_float2(mag * c, mag * s);
      if (d == 1) { ar = mag * c; ai = mag * s; }
    }
    const float nr = ar - 1.f, den = lr * lr + li * li;
    const float sr = (nr * lr + ai * li) / den, si = (ai * lr - nr * li) / den;
    for (int h = 0; h < 16; ++h) {
      const float br = p.b_re[(size_t)(pg * 64 + pp) * 16 + h], bi = p.b_im[(size_t)(pg * 64 + pp) * 16 + h];
      Bbar[((dir * 32 + g) * 64 + pp) * 16 + h] = make_float2(sr * br - si * bi, sr * bi + si * br);
    }
  }
}

DEVI void phase_s5prep2(const Params& p, int L) {
  char* ws = p.ws;
  const float2* Apow = (const float2*)(ws + O_APOW); const float2* Bbar = (const float2*)(ws + O_BBAR);
  float* KFB = (float*)(ws + O_KFB); bf16_t* W1T = (bf16_t*)(ws + O_W1T); bf16_t* W3T = (bf16_t*)(ws + O_W3T);
  const int gtid = blockIdx.x * 512 + otid(), nthr = gridDim.x * 512;
  for (int idx = gtid; idx < 2 * 32 * 32 * 256; idx += nthr) {
    const int hh = idx & 255, h = hh >> 4, h2 = hh & 15, d = (idx >> 8) & 31, g = (idx >> 13) & 31, dir = idx >> 18;
    const int pg = (L * 2 + dir) * 32 + g;
    const float* cr = p.c_re + (size_t)(pg * 16 + h) * 64; const float* ci = p.c_im + (size_t)(pg * 16 + h) * 64;
    const float2* A = Apow + ((dir * 32 + g) * 33 + d) * 64; const float2* Bb = Bbar + ((dir * 32 + g) * 64) * 16 + h2;
    float val = 0.f;
    for (int pp = 0; pp < 64; ++pp) {
      const float2 a = A[pp], b = Bb[pp * 16];
      const float tr = cr[pp] * a.x - ci[pp] * a.y, ti = cr[pp] * a.y + ci[pp] * a.x;
      val += tr * b.x - ti * b.y;
    }
    KFB[idx] = val;
  }
  for (int idx = gtid; idx < 32 * 256 * 512; idx += nthr) {
    const int k = idx & 511, n = (idx >> 9) & 255, g = idx >> 17;
    const int dir = n >> 7, reim = (n >> 6) & 1, pp = n & 63, j = k >> 4, h2 = k & 15;
    const int e = dir == 0 ? 31 - j : j;
    const float2 a = Apow[((dir * 32 + g) * 33 + e) * 64 + pp], b = Bbar[((dir * 32 + g) * 64 + pp) * 16 + h2];
    const float vr = a.x * b.x - a.y * b.y, vi = a.x * b.y + a.y * b.x;
    W1T[idx] = f2bf(reim ? vi : vr);
  }
  for (int idx = gtid; idx < 32 * 512 * 256; idx += nthr) {
    const int kk = idx & 255, n = (idx >> 8) & 511, g = idx >> 17;
    const int dir = kk >> 7, reim = (kk >> 6) & 1, pp = kk & 63, j = n >> 4, h = n & 15;
    const int e = dir == 0 ? j + 1 : 32 - j;
    const int pg = (L * 2 + dir) * 32 + g;
    const float cr = p.c_re[(size_t)(pg * 16 + h) * 64 + pp], ci = p.c_im[(size_t)(pg * 16 + h) * 64 + pp];
    const float2 a = Apow[((dir * 32 + g) * 33 + e) * 64 + pp];
    const float vr = cr * a.x - ci * a.y, vi = cr * a.y + ci * a.x;
    W3T[(size_t)(g * 512 + n) * 768 + 512 + kk] = f2bf(reim ? -vi : vr);
  }
}

DEVI void phase_s5prep3(const Params& p, int L) {
  char* ws = p.ws;
  const float* KFB = (const float*)(ws + O_KFB); bf16_t* W3T = (bf16_t*)(ws + O_W3T);
  const int gtid = blockIdx.x * 512 + otid(), nthr = gridDim.x * 512;
  for (int idx = gtid; idx < 32 * 512 * 512; idx += nthr) {
    const int k = idx & 511, n = (idx >> 9) & 511, g = idx >> 18;
    const int s = k >> 4, h2 = k & 15, j = n >> 4, h = n & 15;
    float val = 0.f;
    if (s <= j) val += KFB[((0 * 32 + g) * 32 + (j - s)) * 256 + h * 16 + h2];
    if (s >= j) val += KFB[((1 * 32 + g) * 32 + (s - j)) * 256 + h * 16 + h2];
    if (s == j && h == h2) val += p.ssm_d[L * 512 + g * 16 + h];
    W3T[(size_t)(g * 512 + n) * 768 + k] = f2bf(val);
  }
}

DEVI void phase_rope_table(const Params& p) {
  float2* rope = (float2*)(p.ws + O_ROPE);
  const int gtid = blockIdx.x * 512 + otid(), nthr = gridDim.x * 512;
  for (int idx = gtid; idx < 16400 * 32; idx += nthr) {
    const int i = idx & 31, pos = idx >> 5;
    const float ang = (float)pos * p.inv[i];
    float c, s; sincos_rev((double)ang, c, s);
    rope[idx] = make_float2(c, s);
  }
}

DEVI const float* hrow_c(const Params& p, int m) { return m < NREAL ? p.out + (size_t)m * 1024 : (const float*)(p.ws + O_HMETA) + (size_t)(m - META0) * 1024; }

DEVI void phase_norm(const Params& p, const float* __restrict__ gain, bf16_t* __restrict__ xn, bool from_input, int ld = 1024) {
  const int lane = otid() & 63;
  const int wgid = blockIdx.x * 8 + (otid() >> 6), nwaves = gridDim.x * 8;
  f32x4 g4[4];
#pragma unroll
  for (int i = 0; i < 4; ++i) g4[i] = *(const f32x4*)(gain + i * 256 + lane * 4);
  for (int m0 = wgid; m0 < MPAD; m0 += 2 * nwaves) {
    f32x4 v[2][4]; bool val[2];
#pragma unroll
    for (int j = 0; j < 2; ++j) {
      const int m = m0 + j * nwaves; val[j] = m < MPAD;
      const float* src = nullptr; bool zero = !val[j];
      if (val[j]) {
        if (from_input) {
          if (m < 32768) src = p.x_prompt + (size_t)m * 1024;
          else if (m < NREAL) src = p.x_sample + (size_t)(m - 32768) * 1024;
          else { const int lr = m - META0; if (is_pad_lr(lr)) zero = true; else src = p.meta + (size_t)((lr & 63) - 48) * 1024; }
        } else src = hrow_c(p, m);
      }
#pragma unroll
      for (int i = 0; i < 4; ++i) { if (zero) v[j][i] = (f32x4){0.f, 0.f, 0.f, 0.f}; else v[j][i] = __builtin_nontemporal_load((const f32x4*)(src + i * 256 + lane * 4)); }
    }
#pragma unroll
    for (int j = 0; j < 2; ++j) {
      if (!val[j]) continue;
      const int m = m0 + j * nwaves;
      float ss = 0.f;
#pragma unroll
      for (int i = 0; i < 4; ++i) ss += v[j][i][0] * v[j][i][0] + v[j][i][1] * v[j][i][1] + v[j][i][2] * v[j][i][2] + v[j][i][3] * v[j][i][3];
#pragma unroll
      for (int o = 32; o >= 1; o >>= 1) ss += __shfl_xor(ss, o);
      const float rstd = rsqrtf(ss * (1.f / 1024.f) + 1e-6f);
#pragma unroll
      for (int i = 0; i < 4; ++i) {
        u32x2 w; w.x = cvtpk(v[j][i][0] * rstd * g4[i][0], v[j][i][1] * rstd * g4[i][1]); w.y = cvtpk(v[j][i][2] * rstd * g4[i][2], v[j][i][3] * rstd * g4[i][3]);
        __builtin_nontemporal_store(w, (u32x2*)(xn + (size_t)m * ld + i * 256 + lane * 4));
      }
      if (from_input && m >= META0) {
        float* hm = (float*)(p.ws + O_HMETA) + (size_t)(m - META0) * 1024;
#pragma unroll
        for (int i = 0; i < 4; ++i) *(f32x4*)(hm + i * 256 + lane * 4) = v[j][i];
      }
    }
  }
}

DEVI void phase_final_norm(const Params& p) {
  const int lane = otid() & 63;
  const int wgid = blockIdx.x * 8 + (otid() >> 6), nwaves = gridDim.x * 8;
  f32x4 g4[4];
#pragma unroll
  for (int i = 0; i < 4; ++i) g4[i] = *(const f32x4*)(p.norm_final + i * 256 + lane * 4);
  for (int m = wgid; m < NREAL; m += nwaves) {
    float* row = p.out + (size_t)m * 1024;
    f32x4 v[4]; float ss = 0.f;
#pragma unroll
    for (int i = 0; i < 4; ++i) { v[i] = __builtin_nontemporal_load((const f32x4*)(row + i * 256 + lane * 4)); ss += v[i][0] * v[i][0] + v[i][1] * v[i][1] + v[i][2] * v[i][2] + v[i][3] * v[i][3]; }
#pragma unroll
    for (int o = 32; o >= 1; o >>= 1) ss += __shfl_xor(ss, o);
    const float rstd = rsqrtf(ss * (1.f / 1024.f) + 1e-6f);
#pragma unroll
    for (int i = 0; i < 4; ++i) { f32x4 w = v[i] * rstd * g4[i]; __builtin_nontemporal_store(w, (f32x4*)(row + i * 256 + lane * 4)); }
  }
}

DEVI void phase_carry(const Params& p) {
  char* ws = p.ws;
  const float2* Apow = (const float2*)(ws + O_APOW);
  const float* Sloc = (const float*)(ws + O_ARENA + A_SLOC); bf16_t* carry = (bf16_t*)(ws + O_ARENA + A_CARRY);
  const int gtid = blockIdx.x * 512 + otid(), nthr = gridDim.x * 512;
  for (int idx = gtid; idx < 10 * 32 * 2 * 64; idx += nthr) {
    const int pp = idx & 63, dir = (idx >> 6) & 1, g = (idx >> 7) & 31, seq = idx >> 12;
    const float2 aT = Apow[((dir * 32 + g) * 33 + 32) * 64 + pp];
    const int len = seq < 2 ? 16384 : 2048;
    const int rb = seq < 2 ? seq * 16384 : 32768 + (seq - 2) * 2048;
    const int n = 2 + len / 32, mc0 = (META0 + 64 * seq) / 32, rc0 = rb / 32;
    float cr = 0.f, ci = 0.f;
    const int col = g * 256 + dir * 128 + pp;
#pragma unroll 1
    for (int b0 = 0; b0 < n; b0 += 8) {
      float sr[8], si[8]; int off[8];
#pragma unroll
      for (int k = 0; k < 8; ++k) {
        int ii = b0 + k; if (ii > n - 1) ii = n - 1;
        const int i = dir == 0 ? ii : n - 1 - ii;
        const int ch = i < 2 ? mc0 + i : rc0 + (i - 2);
        off[k] = ch * 8192 + col;
        sr[k] = Sloc[off[k]]; si[k] = Sloc[off[k] + 64];
      }
#pragma unroll
      for (int k = 0; k < 8; ++k) {
        if (b0 + k < n) {
          carry[off[k]] = f2bf(cr); carry[off[k] + 64] = f2bf(ci);
          const float nr = aT.x * cr - aT.y * ci + sr[k], ni = aT.x * ci + aT.y * cr + si[k];
          cr = nr; ci = ni;
        }
      }
    }
  }
}

DEVI void phase_latent_rstd(const Params& p) {
  char* ar = p.ws + O_ARENA;
  const bf16_t* cq = (const bf16_t*)(ar + A_CQ); const bf16_t* ckv = (const bf16_t*)(ar + A_CKV);
  float* rs = (float*)(p.ws + O_RSTD);
  const int tid = otid(), l32 = tid & 31;
  const int hw = blockIdx.x * 16 + (tid >> 5), nhw = gridDim.x * 16;
  for (int m = hw; m < MPAD; m += nhw) {
    float sq = 0.f, sk = 0.f;
#pragma unroll
    for (int i = 0; i < 3; ++i) { const f32x4 v = unpack4(*(const u32x2*)(cq + (size_t)m * 384 + i * 128 + l32 * 4)); sq += v[0] * v[0] + v[1] * v[1] + v[2] * v[2] + v[3] * v[3]; }
#pragma unroll
    for (int i = 0; i < 2; ++i) { const f32x4 v = unpack4(*(const u32x2*)(ckv + (size_t)m * 256 + i * 128 + l32 * 4)); sk += v[0] * v[0] + v[1] * v[1] + v[2] * v[2] + v[3] * v[3]; }
#pragma unroll
    for (int o = 16; o >= 1; o >>= 1) { sq += __shfl_xor(sq, o); sk += __shfl_xor(sk, o); }
    if (l32 == 0) { rs[m * 2] = rsqrtf(sq * (1.f / 384.f) + 1e-6f); rs[m * 2 + 1] = rsqrtf(sk * (1.f / 256.f) + 1e-6f); }
  }
}

template <int MI, class F>
DEVI void epi_tile(const f32x16 (&acc)[MI][2], char* lds, F f) {
  const int lane = otid() & 63, wid = otid() >> 6, r32 = lane & 31, hi = lane >> 5;
  float* blk = (float*)(lds + wid * 8192);
#pragma unroll
  for (int mi = 0; mi < MI; ++mi) {
#pragma unroll
    for (int ni = 0; ni < 2; ++ni)
#pragma unroll
      for (int r = 0; r < 16; ++r) blk[crow(r, hi) * 64 + ni * 32 + r32] = acc[mi][ni][r];
    asm volatile("s_waitcnt lgkmcnt(0)" ::: "memory");
    __builtin_amdgcn_wave_barrier();
#pragma unroll
    for (int q = 0; q < 8; ++q) {
      const int row = q * 4 + (lane >> 4), col = (lane & 15) * 4;
      const f32x4 v = *(const f32x4*)(blk + row * 64 + col);
      f(mi * 32 + row, col, v);
    }
    asm volatile("s_waitcnt lgkmcnt(0)" ::: "memory");
    __builtin_amdgcn_wave_barrier();
  }
}
template <int MI, class F>
DEVI void epi_tile_pair(const f32x16 (&acc)[MI][2], char* lds, F f) {
  const int lane = otid() & 63, wid = otid() >> 6, r32 = lane & 31, hi = lane >> 5;
  float* blk = (float*)(lds + wid * 8192);
#pragma unroll
  for (int mi = 0; mi < MI; ++mi) {
#pragma unroll
    for (int ni = 0; ni < 2; ++ni)
#pragma unroll
      for (int r = 0; r < 16; ++r) blk[crow(r, hi) * 64 + ni * 32 + r32] = acc[mi][ni][r];
    asm volatile("s_waitcnt lgkmcnt(0)" ::: "memory");
    __builtin_amdgcn_wave_barrier();
#pragma unroll
    for (int q = 0; q < 4; ++q) {
      const int row = q * 8 + (lane >> 3), col = (lane & 7) * 4;
      const f32x4 v1 = *(const f32x4*)(blk + row * 64 + col);
      const f32x4 v2 = *(const f32x4*)(blk + row * 64 + 32 + col);
      f(mi * 32 + row, col, v1, v2);
    }
    asm volatile("s_waitcnt lgkmcnt(0)" ::: "memory");
    __builtin_amdgcn_wave_barrier();
  }
}
DEVI u32x2 pack4(f32x4 v) { u32x2 w; w.x = cvtpk(v[0], v[1]); w.y = cvtpk(v[2], v[3]); return w; }

template <int MI, class PT, class P, class F>
DEVI void epi_tile_pf(const f32x16 (&acc)[MI][2], char* lds, P pre, F f) {
  const int lane = otid() & 63, wid = otid() >> 6, r32 = lane & 31, hi = lane >> 5;
  float* blk = (float*)(lds + wid * 8192);
#pragma unroll
  for (int mi = 0; mi < MI; ++mi) {
    PT pv[8];
#pragma unroll
    for (int q = 0; q < 8; ++q) pv[q] = pre(mi * 32 + q * 4 + (lane >> 4), (lane & 15) * 4);
#pragma unroll
    for (int ni = 0; ni < 2; ++ni)
#pragma unroll
      for (int r = 0; r < 16; ++r) blk[crow(r, hi) * 64 + ni * 32 + r32] = acc[mi][ni][r];
    asm volatile("s_waitcnt lgkmcnt(0)" ::: "memory");
    __builtin_amdgcn_wave_barrier();
#pragma unroll
    for (int q = 0; q < 8; ++q) {
      const int row = q * 4 + (lane >> 4), col = (lane & 15) * 4;
      const f32x4 v = *(const f32x4*)(blk + row * 64 + col);
      f(mi * 32 + row, col, v, pv[q]);
    }
    asm volatile("s_waitcnt lgkmcnt(0)" ::: "memory");
    __builtin_amdgcn_wave_barrier();
  }
}
DEVI void phase_proj(const Params& p, char* lds) {
  char* ar = p.ws + O_ARENA;
  const bf16_t* xn = (const bf16_t*)(ar + A_XN1); const bf16_t* W = (const bf16_t*)(p.ws + O_WIN);
  bf16_t* u = (bf16_t*)(ar + A_U); bf16_t* cq = (bf16_t*)(ar + A_CQ); bf16_t* ckv = (bf16_t*)(ar + A_CKV); bf16_t* kr = (bf16_t*)(ar + A_KR);
  const float2* rope = (const float2*)(p.ws + O_ROPE);
  const int wid = otid() >> 6, wm = wid >> 2, wn = wid & 3;
  GStage<2> st;
  int nt, mt; bool have = unit_xcd(0, 390, 5, mt, nt);
  if (have) gemm_prefetch<2>(st, xn + (size_t)mt * 128 * 1024, 1024, 128, 30, 0, W + (size_t)nt * 256 * 1024, 1024, 1024);
  for (int ui = 0; have; ++ui) {
    f32x16 acc[2][2]; zero_acc<2>(acc);
    gemm_main<2, 2, 4>(acc, st, xn + (size_t)mt * 128 * 1024, 1024, 128, 30, 0, W + (size_t)nt * 256 * 1024, 1024, 1024, lds);
    int nt2, mt2; const bool hn = unit_xcd(ui + 1, 390, 5, mt2, nt2);
    if (hn) gemm_prefetch<2>(st, xn + (size_t)mt2 * 128 * 1024, 1024, 128, 30, 0, W + (size_t)nt2 * 256 * 1024, 1024, 1024);
    const int nb = nt * 256 + wn * 64, m0 = mt * 128 + wm * 64;
    if (nb < 1152) {
      bf16_t* dst; int ld, c0;
      if (nb < 512) { dst = u; ld = 512; c0 = nb; } else if (nb < 896) { dst = cq; ld = 384; c0 = nb - 512; } else { dst = ckv; ld = 256; c0 = nb - 896; }
      dst += (size_t)m0 * ld + c0;
      epi_tile<2>(acc, lds, [&](int row, int col, f32x4 v) { *(u32x2*)(dst + row * ld + col) = pack4(v); });
    } else if (nb == 1152) {
      bf16_t* dst = kr + (size_t)m0 * 64;
      epi_tile_pair<2>(acc, lds, [&](int row, int col, f32x4 x1, f32x4 x2) {
        const float2* cs = rope + pos_of_row(m0 + row) * 32 + col;
        f32x4 o1, o2;
#pragma unroll
        for (int e = 0; e < 4; ++e) { const float2 c = cs[e]; o1[e] = x1[e] * c.x - x2[e] * c.y; o2[e] = x1[e] * c.y + x2[e] * c.x; }
        *(u32x2*)(dst + row * 64 + col) = pack4(o1); *(u32x2*)(dst + row * 64 + 32 + col) = pack4(o2);
      });
    }
    mt = mt2; nt = nt2; have = hn;
  }
}

DEVI void phase_s5a1(const Params& p, char* lds) {
  char* ar = p.ws + O_ARENA;
  const bf16_t* u = (const bf16_t*)(ar + A_U); const bf16_t* W1T = (const bf16_t*)(p.ws + O_W1T); float* Sloc = (float*)(ar + A_SLOC);
  const int wid = otid() >> 6, wm = wid >> 2, wn = wid & 3;
  for (int un = blockIdx.x; un < 13 * 32; un += gridDim.x) {
    const int g = un & 31, rt = un >> 5;
    f32x16 acc[2][2]; zero_acc<2>(acc);
    gemm_acc<2>(acc, u + (size_t)rt * 128 * 16384 + g * 16, 16384, NCHUNK - rt * 128, 4, 512, W1T + (size_t)g * 256 * 512, 512, 512, lds);
    float* dst = Sloc + ((size_t)(rt * 128 + wm * 64) * 32 + g) * 256 + wn * 64;
    epi_tile<2>(acc, lds, [&](int row, int col, f32x4 v) { *(f32x4*)(dst + row * 8192 + col) = v; });
  }
}

DEVI void phase_s5a3(const Params& p, char* lds) {
  char* ar = p.ws + O_ARENA;
  const bf16_t* u = (const bf16_t*)(ar + A_U); const bf16_t* carry = (const bf16_t*)(ar + A_CARRY);
  const bf16_t* W3T = (const bf16_t*)(p.ws + O_W3T); bf16_t* z1 = (bf16_t*)(ar + A_Z1);
  const int wid = otid() >> 6, wm = wid >> 2, wn = wid & 3;
  for (int un = blockIdx.x; un < 13 * 32 * 2; un += gridDim.x) {
    const int nt = un & 1, g = (un >> 1) & 31, rt = un >> 6;
    f32x16 acc[2][2]; zero_acc<2>(acc);
    const bf16_t* Bt = W3T + (size_t)(g * 512 + nt * 256) * 768;
    gemm_acc<2>(acc, u + (size_t)rt * 128 * 16384 + g * 16, 16384, NCHUNK - rt * 128, 4, 512, Bt, 768, 512, lds);
    gemm_acc<2>(acc, carry + (size_t)rt * 128 * 8192 + g * 256, 8192, 128, 30, 0, Bt + 512, 768, 256, lds);
    const int c0 = rt * 128 + wm * 64, nb = nt * 256 + wn * 64;
    bf16_t* dst = z1 + (size_t)c0 * 16384 + g * 16;
    epi_tile<2>(acc, lds, [&](int row, int col, f32x4 v) {
      if (c0 + row < NCHUNK) {
        const int n = nb + col, j = n >> 4, h = n & 15;
        f32x4 o;
#pragma unroll
        for (int e = 0; e < 4; ++e) { const float y = v[e]; const float t = 1.5957691216057308f * (y + 0.044715f * y * y * y); o[e] = y * sigmoidf_(t); }
        *(u32x2*)(dst + row * 16384 + j * 512 + h) = pack4(o);
      }
    });
  }
}

DEVI void phase_glu(const Params& p, int L, char* lds) {
  char* ar = p.ws + O_ARENA;
  const bf16_t* z1 = (const bf16_t*)(ar + A_Z1); const bf16_t* W = (const bf16_t*)(p.ws + O_WGLU); bf16_t* z2 = (bf16_t*)(ar + A_Z2);
  const float* bg = p.b_glu + L * 512;
  const int wid = otid() >> 6, wm = wid >> 2, wn = wid & 3;
  for (int ui = 0;; ++ui) {
    int nt, mt; if (!unit_xcd(ui, 390, 2, mt, nt)) break;
    f32x16 acc[2][2]; zero_acc<2>(acc);
    gemm_acc<2>(acc, z1 + (size_t)mt * 128 * 512, 512, 128, 30, 0, W + (size_t)nt * 256 * 512, 512, 512, lds);
    const int nb = nt * 256 + wn * 64, m0 = mt * 128 + wm * 64;
    const bf16_t* src = z1 + (size_t)m0 * 512 + nb; bf16_t* dst = z2 + (size_t)m0 * 512 + nb; const float* bb = bg + nb;
    epi_tile_pf<2, u32x2>(acc, lds, [&](int row, int col) { return *(const u32x2*)(src + row * 512 + col); },
                          [&](int row, int col, f32x4 v, u32x2 zz) {
      const f32x4 z = unpack4(zz);
      const f32x4 b = *(const f32x4*)(bb + col);
      f32x4 o;
#pragma unroll
      for (int e = 0; e < 4; ++e) o[e] = z[e] * sigmoidf_(v[e] + b[e]);
      *(u32x2*)(dst + row * 512 + col) = pack4(o);
    });
  }
}

DEVI void phase_qkv(const Params& p, int grp, char* lds) {
  char* ar = p.ws + O_ARENA;
  const bf16_t* cq = (const bf16_t*)(ar + A_CQ); const bf16_t* ckv = (const bf16_t*)(ar + A_CKV);
  bf16_t* qg = (bf16_t*)(ar + A_QG); bf16_t* kvg = (bf16_t*)(ar + A_KVG);
  const bf16_t* Wq = (const bf16_t*)(p.ws + O_WUQ); const bf16_t* Wkv = (const bf16_t*)(p.ws + O_WUKV);
  const float2* rope = (const float2*)(p.ws + O_ROPE);
  float* rstd_l = (float*)(lds + 131072);
  const int tid = otid(), wid = tid >> 6, wm = wid >> 2, wn = wid & 3;
  const int greal0 = grp * 16384, seq0 = grp < 2 ? grp : 2;
  for (int un = blockIdx.x; un < 132 * 14; un += gridDim.x) {
    const bool iskv = un < 132 * 8;
    const int v = iskv ? un : un - 132 * 8;
    const int nt = iskv ? (v & 7) : (v % 6), lt = iskv ? (v >> 3) : (v / 6);
    const int gb = lt < 128 ? greal0 + lt * 128 : META0 + 64 * seq0 + (lt - 128) * 128;
    const int arows = MPAD - gb;
    const int KL = iskv ? 256 : 384;
    const bf16_t* A = (iskv ? ckv : cq) + (size_t)gb * KL;
    if (tid < 128) { int gr = gb + tid; if (gr > MPAD - 1) gr = MPAD - 1; rstd_l[tid] = ((const float*)(p.ws + O_RSTD))[gr * 2 + (iskv ? 1 : 0)]; }
    f32x16 acc[2][2]; zero_acc<2>(acc);
    gemm_acc<2>(acc, A, KL, arows, 30, 0, (iskv ? Wkv : Wq) + (size_t)nt * 256 * KL, KL, KL, lds);
    const int nb = nt * 256 + wn * 64, ml0 = wm * 64;
    const bool ropeslab = !iskv && ((nb >> 6) % 3) == 2;
    if (!ropeslab) {
      const int ld = iskv ? 2048 : 1536;
      bf16_t* dst = (iskv ? kvg : qg) + (size_t)(lt * 128 + ml0) * ld + nb;
      epi_tile<2>(acc, lds, [&](int row, int col, f32x4 vv) {
        const float rs = rstd_l[ml0 + row];
        *(u32x2*)(dst + row * ld + col) = pack4(vv * rs);
      });
    } else {
      bf16_t* dst = qg + (size_t)(lt * 128 + ml0) * 1536 + nb;
      epi_tile_pair<2>(acc, lds, [&](int row, int col, f32x4 x1, f32x4 x2) {
        int gm = gb + ml0 + row; if (gm >= MPAD) gm = MPAD - 1;
        const float2* cs = rope + pos_of_row(gm) * 32 + col;
        const float rs = rstd_l[ml0 + row];
        f32x4 o1, o2;
#pragma unroll
        for (int e = 0; e < 4; ++e) { const float2 c = cs[e]; const float a = x1[e] * rs, b = x2[e] * rs; o1[e] = a * c.x - b * c.y; o2[e] = a * c.y + b * c.x; }
        *(u32x2*)(dst + row * 1536 + col) = pack4(o1); *(u32x2*)(dst + row * 1536 + 32 + col) = pack4(o2);
      });
    }
    __syncthreads();
  }
}

DEVI void phase_merge(const Params& p, char* lds) {
  constexpr int MIV = 2;
  char* ar = p.ws + O_ARENA;
  const bf16_t* xn = (const bf16_t*)(ar + A_XN2); const bf16_t* z2 = (const bf16_t*)(ar + A_Z2); const bf16_t* o = (const bf16_t*)(ar + A_O);
  bf16_t* mg = (bf16_t*)(ar + A_MERGED);
  const bf16_t* Wg = (const bf16_t*)(p.ws + O_WG); const bf16_t* Wssm = (const bf16_t*)(p.ws + O_WSSM); const bf16_t* Wattn = (const bf16_t*)(p.ws + O_WATTN);
  const int wid = otid() >> 6, wm = wid >> 2, wn = wid & 3;
  GStage<2> st;
  int nt, mt; bool have = unit_xcd(0, 390, 4, mt, nt);
  if (have) gemm_prefetch<2>(st, xn + (size_t)mt * 128 * 1024, 1024, 128, 30, 0, Wg + (size_t)(nt * 256) * 1024, 1024, 1024);
  for (int ui = 0; have; ++ui) {
    const int nb = nt * 256 + wn * 64, m0 = mt * 128 + wm * 64;
    bf16_t* dst = mg + (size_t)m0 * 1024 + nb;
    unsigned spk[2][2][8];
    f32x16 acc[2][2];
    zero_acc<2>(acc);
    gemm_main<2>(acc, st, xn + (size_t)mt * 128 * 1024, 1024, 128, 30, 0, Wg + (size_t)(nt * 256) * 1024, 1024, 1024, lds);
    gemm_prefetch<2>(st, z2 + (size_t)mt * 128 * 512, 512, 128, 30, 0, Wssm + (size_t)(nt * 256) * 512, 512, 512);
    FOR_MN(mi, ni) {
#pragma unroll
      for (int q = 0; q < 8; ++q) spk[mi][ni][q] = cvtpk(sigmoidf_(acc[mi][ni][2 * q]), sigmoidf_(acc[mi][ni][2 * q + 1]));
    }
    zero_acc<2>(acc);
    gemm_main<2>(acc, st, z2 + (size_t)mt * 128 * 512, 512, 128, 30, 0, Wssm + (size_t)(nt * 256) * 512, 512, 512, lds);
    gemm_prefetch<2>(st, xn + (size_t)mt * 128 * 1024, 1024, 128, 30, 0, Wg + (size_t)(1024 + nt * 256) * 1024, 1024, 1024);
    FOR_MN(mi, ni) {
#pragma unroll
      for (int q = 0; q < 8; ++q) {
        const unsigned w = spk[mi][ni][q];
        acc[mi][ni][2 * q] *= __uint_as_float(w << 16); acc[mi][ni][2 * q + 1] *= __uint_as_float(w & 0xffff0000u);
      }
    }
    epi_tile<2>(acc, lds, [&](int row, int col, f32x4 v) { *(u32x2*)(dst + row * 1024 + col) = pack4(v); });
    zero_acc<2>(acc);
    gemm_main<2>(acc, st, xn + (size_t)mt * 128 * 1024, 1024, 128, 30, 0, Wg + (size_t)(1024 + nt * 256) * 1024, 1024, 1024, lds);
    gemm_prefetch<2>(st, o + (size_t)mt * 128 * 1024, 1024, 128, 30, 0, Wattn + (size_t)(nt * 256) * 1024, 1024, 1024);
    FOR_MN(mi, ni) {
#pragma unroll
      for (int q = 0; q < 8; ++q) spk[mi][ni][q] = cvtpk(sigmoidf_(acc[mi][ni][2 * q]), sigmoidf_(acc[mi][ni][2 * q + 1]));
    }
    zero_acc<2>(acc);
    gemm_main<2>(acc, st, o + (size_t)mt * 128 * 1024, 1024, 128, 30, 0, Wattn + (size_t)(nt * 256) * 1024, 1024, 1024, lds);
    int nt2, mt2; const bool hn = unit_xcd(ui + 1, 390, 4, mt2, nt2);
    if (hn) gemm_prefetch<2>(st, xn + (size_t)mt2 * 128 * 1024, 1024, 128, 30, 0, Wg + (size_t)(nt2 * 256) * 1024, 1024, 1024);
    FOR_MN(mi, ni) {
#pragma unroll
      for (int q = 0; q < 8; ++q) {
        const unsigned w = spk[mi][ni][q];
        acc[mi][ni][2 * q] *= __uint_as_float(w << 16); acc[mi][ni][2 * q + 1] *= __uint_as_float(w & 0xffff0000u);
      }
    }
    epi_tile_pf<2, u32x2>(acc, lds, [&](int row, int col) { return *(const u32x2*)(dst + row * 1024 + col); },
                          [&](int row, int col, f32x4 v, u32x2 mm) { *(u32x2*)(dst + row * 1024 + col) = pack4(unpack4(mm) + v); });
    mt = mt2; nt = nt2; have = hn;
  }
}

DEVI void phase_resid_gemm(const Params& p, const bf16_t* __restrict__ A, int K, const bf16_t* __restrict__ Bt, bool layer0_resid, char* lds) {
  const int wid = otid() >> 6, wm = wid >> 2, wn = wid & 3;
  GStage<2> st;
  int nt, mt; bool have = unit_xcd(0, 390, 4, mt, nt);
  if (have) gemm_prefetch<2>(st, A + (size_t)mt * 128 * K, K, 128, 30, 0, Bt + (size_t)(nt * 256) * K, K, K);
  for (int ui = 0; have; ++ui) {
    f32x16 acc[2][2]; zero_acc<2>(acc);
    gemm_main<2, 2, 4>(acc, st, A + (size_t)mt * 128 * K, K, 128, 30, 0, Bt + (size_t)(nt * 256) * K, K, K, lds);
    int nt2, mt2; const bool hn = unit_xcd(ui + 1, 390, 4, mt2, nt2);
    if (hn) gemm_prefetch<2>(st, A + (size_t)mt2 * 128 * K, K, 128, 30, 0, Bt + (size_t)(nt2 * 256) * K, K, K);
    float* hb = mt < 384 ? p.out + (size_t)mt * 128 * 1024 : (float*)(p.ws + O_HMETA) + (size_t)(mt - 384) * 128 * 1024;
    const float* rb = hb;
    if (layer0_resid && mt < 384) rb = mt < 256 ? p.x_prompt + (size_t)mt * 128 * 1024 : p.x_sample + (size_t)(mt - 256) * 128 * 1024;
    const int nb = nt * 256 + wn * 64, ml0 = wm * 64;
    hb += ml0 * 1024 + nb; rb += ml0 * 1024 + nb;
    const int lr0 = mt >= 384 ? (mt - 384) * 128 + ml0 : -1;
    epi_tile_pf<2, f32x4>(acc, lds, [&](int row, int col) { return __builtin_nontemporal_load((const f32x4*)(rb + row * 1024 + col)); },
                          [&](int row, int col, f32x4 v, f32x4 res) {
      f32x4 r = res + v;
      if (lr0 >= 0 && is_pad_lr(lr0 + row)) r = (f32x4){0.f, 0.f, 0.f, 0.f};
      __builtin_nontemporal_store(r, (f32x4*)(hb + row * 1024 + col));
    });
    mt = mt2; nt = nt2; have = hn;
  }
}

DEVI void phase_ffn_up(const Params& p, char* lds) {
  char* ar = p.ws + O_ARENA;
  const bf16_t* xn = (const bf16_t*)(ar + A_XN3); const bf16_t* W = (const bf16_t*)(p.ws + O_WGU); bf16_t* hid = (bf16_t*)(ar + A_HID);
  const int wid = otid() >> 6, wm = wid >> 2, wn = wid & 3;
  for (int ui = 0;; ++ui) {
    int nt, mt; if (!unit_xcd_cb(ui, 195, 22, 4, mt, nt)) break;
    f32x16 acc[4][2]; zero_acc<4>(acc);
    gemm_acc<4, 2>(acc, xn + (size_t)mt * 256 * LDX, LDX, 256, 30, 0, W + (size_t)(nt * 256) * LDX, LDX, 1024, lds);
    bf16_t* dst = hid + (size_t)(mt * 256 + wm * 128) * 2816 + (nt * 4 + wn) * 32;
    epi_tile_pair<4>(acc, lds, [&](int row, int col, f32x4 g, f32x4 uu) {
      f32x4 o;
#pragma unroll
      for (int e = 0; e < 4; ++e) o[e] = g[e] * sigmoidf_(g[e]) * uu[e];
      __builtin_nontemporal_store(pack4(o), (u32x2*)(dst + row * 2816 + col));
    });
  }
}

constexpr float ATT_SCALE = 0.07216878364870322f;
constexpr float ATT_THR = 8.f;
#define KSWZ(row, colB) ((row) * 256 + ((colB) ^ (((row) & 15) << 4)))

DEVI void partialSM(f32x16& p0, f32x16& p1, float& m_reg, float& mn, float& alpha) {
  constexpr float C = ATT_SCALE * 1.4426950408889634f;
  float pmax = p0[0];
#pragma unroll
  for (int r = 1; r < 16; ++r) pmax = fmaxf(pmax, p0[r]);
#pragma unroll
  for (int r = 0; r < 16; ++r) pmax = fmaxf(pmax, p1[r]);
  { auto rr = __builtin_amdgcn_permlane32_swap(__float_as_uint(pmax), __float_as_uint(pmax), false, false);
    pmax = fmaxf(__uint_as_float(rr[0]), __uint_as_float(rr[1])); }
  if (__builtin_expect(__all(pmax - m_reg <= ATT_THR / ATT_SCALE), 1)) { mn = m_reg; alpha = 1.f; }
  else { mn = fmaxf(m_reg, pmax); alpha = __builtin_amdgcn_exp2f((m_reg - mn) * C); m_reg = mn; }
  const float mnC = -mn * C;
#pragma unroll
  for (int r = 0; r < 16; ++r) p0[r] = fmaf(p0[r], C, mnC);
#pragma unroll
  for (int r = 0; r < 16; ++r) p1[r] = fmaf(p1[r], C, mnC);
#pragma unroll
  for (int r = 0; r < 16; ++r) p0[r] = __builtin_amdgcn_exp2f(p0[r]);
}
DEVI void finishSM(f32x16& p0, f32x16& p1, float alpha, float& l_reg, bf16x8& pa0, bf16x8& pa1, bf16x8& pa2, bf16x8& pa3) {
#pragma unroll
  for (int r = 0; r < 16; ++r) p1[r] = __builtin_amdgcn_exp2f(p1[r]);
  float ps = 0;
#pragma unroll
  for (int r = 0; r < 16; ++r) ps += p0[r];
#pragma unroll
  for (int r = 0; r < 16; ++r) ps += p1[r];
  { auto rr = __builtin_amdgcn_permlane32_swap(__float_as_uint(ps), __float_as_uint(ps), false, false);
    ps = __uint_as_float(rr[0]) + __uint_as_float(rr[1]); }
  l_reg = l_reg * alpha + ps;
#define PK4(P, BASE, OUT) do { unsigned a0 = cvtpk(P[BASE + 0], P[BASE + 1]), a1 = cvtpk(P[BASE + 2], P[BASE + 3]);   \
    unsigned b0 = cvtpk(P[BASE + 4], P[BASE + 5]), b1 = cvtpk(P[BASE + 6], P[BASE + 7]);                              \
    auto r0 = __builtin_amdgcn_permlane32_swap(a0, b0, false, false); auto r1 = __builtin_amdgcn_permlane32_swap(a1, b1, false, false); \
    u32x4 w = {r0[0], r1[0], r0[1], r1[1]}; OUT = *reinterpret_cast<bf16x8*>(&w); } while (0)
  PK4(p0, 0, pa0); PK4(p0, 8, pa1); PK4(p1, 0, pa2); PK4(p1, 8, pa3);
#undef PK4
}
DEVI void qkt(f32x16& p0, f32x16& p1, const char* Kn, const char* Kr, const bf16x8* qr, const char* qrl, int r32, int hi) {
#pragma unroll
  for (int r = 0; r < 16; ++r) { p0[r] = 0.f; p1[r] = 0.f; }
#pragma unroll
  for (int d0 = 0; d0 < 8; ++d0) { const int cb = (d0 * 16 + hi * 8) * 2;
    const bf16x8 b0 = *reinterpret_cast<const bf16x8*>(Kn + KSWZ(r32, cb));
    const bf16x8 b1 = *reinterpret_cast<const bf16x8*>(Kn + KSWZ(32 + r32, cb));
    bf16x8 qv;
    if (d0 < 4) qv = qr[d0]; else qv = *reinterpret_cast<const bf16x8*>(qrl + (d0 - 4) * 1024);
    p0 = __builtin_amdgcn_mfma_f32_32x32x16_bf16(b0, qv, p0, 0, 0, 0);
    p1 = __builtin_amdgcn_mfma_f32_32x32x16_bf16(b1, qv, p1, 0, 0, 0); }
  const int swz = (r32 >> 1) & 7;
#pragma unroll
  for (int d0 = 0; d0 < 4; ++d0) { const int so = ((d0 * 2 + hi) ^ swz) << 4;
    const bf16x8 b0 = *reinterpret_cast<const bf16x8*>(Kr + r32 * 128 + so);
    const bf16x8 b1 = *reinterpret_cast<const bf16x8*>(Kr + (32 + r32) * 128 + so);
    const bf16x8 qv = *reinterpret_cast<const bf16x8*>(qrl + (4 + d0) * 1024);
    p0 = __builtin_amdgcn_mfma_f32_32x32x16_bf16(b0, qv, p0, 0, 0, 0);
    p1 = __builtin_amdgcn_mfma_f32_32x32x16_bf16(b1, qv, p1, 0, 0, 0); }
}
DEVI int v_st(int k, int c) { const int kk = (k & ~0xC) | ((k & 4) << 1) | ((k & 8) >> 1); return ((kk >> 3) * 4 + (c >> 5)) * 512 + ((kk & 7) * 32 + (c & 31)) * 2; }
DEVI int v_rd_base(int lane) { return ((lane & 3) << 3) | (((lane >> 2) & 3) << 6) | (((lane >> 4) & 1) << 5) | (((lane >> 5) & 1) << 8); }
constexpr int v_rd_off(int d0, int ks, int half) { return d0 * 512 + ks * 4096 + half * 2048; }
template <int OFF> DEVI s16x4 tr_read(int vb) {
  s16x4 r; asm volatile("ds_read_b64_tr_b16 %0, %1 offset:%2" : "=&v"(r) : "v"(vb), "i"(OFF) : "memory"); return r;
}
template <int D0> DEVI void pv_one(f32x16& od, int vb, bf16x8 pa0, bf16x8 pa1, bf16x8 pa2, bf16x8 pa3) {
  const s16x4 l0 = tr_read<v_rd_off(D0, 0, 0)>(vb), h0 = tr_read<v_rd_off(D0, 0, 1)>(vb), l1 = tr_read<v_rd_off(D0, 1, 0)>(vb), h1 = tr_read<v_rd_off(D0, 1, 1)>(vb);
  const s16x4 l2 = tr_read<v_rd_off(D0, 2, 0)>(vb), h2 = tr_read<v_rd_off(D0, 2, 1)>(vb), l3 = tr_read<v_rd_off(D0, 3, 0)>(vb), h3 = tr_read<v_rd_off(D0, 3, 1)>(vb);
  asm volatile("s_waitcnt lgkmcnt(0)" ::: "memory"); SBAR();
#define PK(L, H) (bf16x8){L[0], L[1], L[2], L[3], H[0], H[1], H[2], H[3]}
  od = __builtin_amdgcn_mfma_f32_32x32x16_bf16(pa0, PK(l0, h0), od, 0, 0, 0);
  od = __builtin_amdgcn_mfma_f32_32x32x16_bf16(pa1, PK(l1, h1), od, 0, 0, 0);
  od = __builtin_amdgcn_mfma_f32_32x32x16_bf16(pa2, PK(l2, h2), od, 0, 0, 0);
  od = __builtin_amdgcn_mfma_f32_32x32x16_bf16(pa3, PK(l3, h3), od, 0, 0, 0);
#undef PK
}
DEVI void pv_d0(f32x16* o, int vb, bf16x8 pa0, bf16x8 pa1, bf16x8 pa2, bf16x8 pa3) {
  pv_one<0>(o[0], vb, pa0, pa1, pa2, pa3); pv_one<1>(o[1], vb, pa0, pa1, pa2, pa3); pv_one<2>(o[2], vb, pa0, pa1, pa2, pa3); pv_one<3>(o[3], vb, pa0, pa1, pa2, pa3);
}

DEVI void attn_unit(const bf16_t* __restrict__ Qg, const bf16_t* __restrict__ KVg, const bf16_t* __restrict__ KR, bf16_t* __restrict__ O,
                    int qrow0, int vlo, int vhi, int orow0, int lmeta, int lreal, int gmeta, int greal, int head, int t0, int NT, float* __restrict__ part, char* lds) {
  const int tid = otid(), wid = tid >> 6, lane = tid & 63, r32 = lane & 31, hi = lane >> 5;
  char* V_lds = lds; char* Kn_lds = lds + 32768; char* Kr_lds = lds + 65536;
  float* wsf = (float*)(lds + 81920) + wid * 64; float* li_l = wsf; float* al_l = wsf + 32;
  float m_reg = -1e30f, l_reg = 0; f32x16 o[4]; bf16x8 qr[4];
  char* qrl = lds + 83968 + wid * 8192 + lane * 16;
#pragma unroll
  for (int d = 0; d < 4; ++d)
#pragma unroll
    for (int r = 0; r < 16; ++r) o[d][r] = 0.f;
  { int qrow = qrow0 + wid * 32 + r32; if (qrow > QG_ROWS - 1) qrow = QG_ROWS - 1;
    const bf16_t* Qw = Qg + (size_t)qrow * 1536 + head * 192 + hi * 8;
#pragma unroll
    for (int d0 = 0; d0 < 4; ++d0) qr[d0] = *reinterpret_cast<const bf16x8*>(Qw + d0 * 16);
#pragma unroll
    for (int d0 = 0; d0 < 8; ++d0) *reinterpret_cast<bf16x8*>(qrl + d0 * 1024) = *reinterpret_cast<const bf16x8*>(Qw + (4 + d0) * 16); }
  const int sr = tid >> 4, sc = (tid & 15) * 8, vst0 = v_st(sr, sc), vst1 = v_st(32 + sr, sc);
  const int krow = tid >> 3, kslot = tid & 7, krofs = krow * 128 + ((kslot ^ ((krow >> 1) & 7)) << 4);
  const int vb0 = (int)(uintptr_t)V_lds + v_rd_base(lane);
  bf16x8 vs0, vs1, ks0, ks1, rs0;
#define SLOAD(j) do { const int jj = t0 + (j); const int lr_ = jj == 0 ? lmeta : lreal + (jj - 1) * 64; const int gr_ = jj == 0 ? gmeta : greal + (jj - 1) * 64; \
    const bf16_t* kvp = KVg + (size_t)(lr_ + sr) * 2048 + head * 256 + sc;                                   \
    ks0 = *reinterpret_cast<const bf16x8*>(kvp); vs0 = *reinterpret_cast<const bf16x8*>(kvp + 128);           \
    ks1 = *reinterpret_cast<const bf16x8*>(kvp + 32 * 2048); vs1 = *reinterpret_cast<const bf16x8*>(kvp + 32 * 2048 + 128); \
    rs0 = *reinterpret_cast<const bf16x8*>(KR + (size_t)(gr_ + krow) * 64 + kslot * 8); } while (0)
#define SWRITE(b) do { *(bf16x8*)(V_lds + (b) * 16384 + vst0) = vs0; *(bf16x8*)(V_lds + (b) * 16384 + vst1) = vs1; const int kc = sc * 2; \
    *(bf16x8*)(Kn_lds + (b) * 16384 + KSWZ(sr, kc)) = ks0; *(bf16x8*)(Kn_lds + (b) * 16384 + KSWZ(32 + sr, kc)) = ks1;    \
    *(bf16x8*)(Kr_lds + (b) * 8192 + krofs) = rs0; } while (0)
#define SWAIT() asm volatile("s_waitcnt vmcnt(0)" ::: "memory")
#define RESC(a) do { if (__any((a) < 1.f)) { if (hi == 0) al_l[r32] = (a); asm volatile("s_waitcnt lgkmcnt(0)" ::: "memory"); \
    _Pragma("unroll") for (int d = 0; d < 4; ++d) _Pragma("unroll") for (int r = 0; r < 16; ++r) o[d][r] *= al_l[crow(r, hi)]; } } while (0)
  f32x16 pA0, pA1, pB0, pB1; float mnA, mnB, alA, alB; bf16x8 pa0, pa1, pa2, pa3;
  SLOAD(0); SWAIT(); SWRITE(0); __syncthreads();
  qkt(pA0, pA1, Kn_lds, Kr_lds, qr, qrl, r32, hi);
  if (t0 == 0) {
#pragma unroll
    for (int r = 0; r < 16; ++r) pA0[r] = -1e30f;
#pragma unroll
    for (int r = 0; r < 8; ++r) pA1[r] = -1e30f;
  }
  partialSM(pA0, pA1, m_reg, mnA, alA);
  if (NT > 1) { SLOAD(1); SWAIT(); SWRITE(1); }
  __syncthreads();
  for (int j = 1; j + 1 < NT; j += 2) {
    SBAR(); qkt(pB0, pB1, Kn_lds + 16384, Kr_lds + 8192, qr, qrl, r32, hi);
    finishSM(pA0, pA1, alA, l_reg, pa0, pa1, pa2, pa3); SBAR();
    SLOAD(j + 1); SBAR();
    pv_d0(o, vb0, pa0, pa1, pa2, pa3); partialSM(pB0, pB1, m_reg, mnB, alB);
    __syncthreads(); SWAIT(); SWRITE(0);
    RESC(alB); __syncthreads();
    SBAR(); qkt(pA0, pA1, Kn_lds, Kr_lds, qr, qrl, r32, hi);
    finishSM(pB0, pB1, alB, l_reg, pa0, pa1, pa2, pa3); SBAR();
    if (j + 2 < NT) SLOAD(j + 2); SBAR();
    pv_d0(o, vb0 + 16384, pa0, pa1, pa2, pa3); partialSM(pA0, pA1, m_reg, mnA, alA);
    __syncthreads(); SWAIT(); SWRITE(1);
    RESC(alA); __syncthreads();
  }
  if ((NT & 1) == 0) {
    SBAR(); qkt(pB0, pB1, Kn_lds + 16384, Kr_lds + 8192, qr, qrl, r32, hi);
    finishSM(pA0, pA1, alA, l_reg, pa0, pa1, pa2, pa3); SBAR();
    pv_d0(o, vb0, pa0, pa1, pa2, pa3); partialSM(pB0, pB1, m_reg, mnB, alB);
    __syncthreads(); RESC(alB);
    finishSM(pB0, pB1, alB, l_reg, pa0, pa1, pa2, pa3); SBAR();
    pv_d0(o, vb0 + 16384, pa0, pa1, pa2, pa3);
  } else {
    finishSM(pA0, pA1, alA, l_reg, pa0, pa1, pa2, pa3); SBAR();
    pv_d0(o, vb0, pa0, pa1, pa2, pa3);
  }
  if (part) {
    if (wid == 1) {
      if (hi == 0 && r32 >= 16) { part[2048 + r32 - 16] = m_reg; part[2064 + r32 - 16] = l_reg; }
#pragma unroll
      for (int r = 8; r < 16; ++r) {
        float* pw = part + (crow(r, hi) - 16) * 128 + r32;
#pragma unroll
        for (int d0 = 0; d0 < 4; ++d0) pw[d0 * 32] = o[d0][r];
      }
    }
  } else {
  if (hi == 0) li_l[r32] = l_reg; asm volatile("s_waitcnt lgkmcnt(0)" ::: "memory");
  float rli[16];
#pragma unroll
  for (int r = 0; r < 16; ++r) rli[r] = __builtin_amdgcn_rcpf(li_l[crow(r, hi)]);
#pragma unroll
  for (int r = 0; r < 16; ++r) {
    const int rb = wid * 32 + crow(r, hi);
    if (rb >= vlo && rb < vhi) {
      bf16_t* Ow = O + (size_t)(orow0 + rb) * 1024 + head * 128 + r32;
#pragma unroll
      for (int d0 = 0; d0 < 4; ++d0) Ow[d0 * 32] = f2bf(o[d0][r] * rli[r]);
    }
  }
  }
#undef SLOAD
#undef SWRITE
#undef SWAIT
#undef RESC
}

constexpr size_t A_PART = 344752128;
constexpr int PART_STRIDE = 16 * 128 + 32;
DEVI void phase_attn(const Params& p, int grp, char* lds) {
  char* ar = p.ws + O_ARENA;
  const bf16_t* qg = (const bf16_t*)(ar + A_QG); const bf16_t* kvg = (const bf16_t*)(ar + A_KVG); const bf16_t* kr = (const bf16_t*)(ar + A_KR);
  bf16_t* o = (bf16_t*)(ar + A_O); float* part = (float*)(ar + A_PART);
  const int nseq = grp < 2 ? 1 : 8, S = grp < 2 ? 16384 : 2048, nqb = S / 256;
  const int NS = grp < 2 ? 32 : 4;
  const int NUR = nseq * 8 * nqb, NU = NUR + nseq * 8 * NS, NT = 1 + S / 64;
  for (int un = blockIdx.x; un < NU; un += gridDim.x) {
    __syncthreads();
    if (un < NUR) {
      const int head = un & 7, t = un >> 3, sl = t / nqb, qb = t % nqb;
      const int seq = grp < 2 ? grp : 2 + sl;
      const int lreal = sl * S, lmeta = 16384 + 64 * sl;
      const int greal = grp < 2 ? grp * 16384 : 32768 + sl * 2048, gmeta = META0 + 64 * seq;
      attn_unit(qg, kvg, kr, o, lreal + qb * 256, 0, 256, greal + qb * 256, lmeta, lreal, gmeta, greal, head, 0, NT, nullptr, lds);
    } else {
      const int v = un - NUR, sp = v % NS, hs = v / NS, head = hs & 7, sl = hs >> 3;
      const int seq = grp < 2 ? grp : 2 + sl;
      const int lreal = sl * S, lmeta = 16384 + 64 * sl;
      const int greal = grp < 2 ? grp * 16384 : 32768 + sl * 2048, gmeta = META0 + 64 * seq;
      const int ta = (sp * NT) / NS, tb = ((sp + 1) * NT) / NS;
      const int pu = grp < 2 ? (grp * 8 + head) * 32 + sp : 512 + (sl * 8 + head) * 4 + sp;
      attn_unit(qg, kvg, kr, o, lmeta, 0, 0, gmeta, lmeta, lreal, gmeta, greal, head, ta, tb - ta, part + (size_t)pu * PART_STRIDE, lds);
    }
  }
}

DEVI void phase_attn_combine(const Params& p) {
  char* ar = p.ws + O_ARENA;
  const float* part = (const float*)(ar + A_PART); bf16_t* o = (bf16_t*)(ar + A_O);
  constexpr float C = ATT_SCALE * 1.4426950408889634f;
  const int gtid = blockIdx.x * 512 + otid(), nthr = gridDim.x * 512;
  for (int it = gtid; it < 10 * 8 * 16 * 128; it += nthr) {
    const int col = it & 127, row = (it >> 7) & 15, head = (it >> 11) & 7, seq = it >> 14;
    const int NS = seq < 2 ? 32 : 4;
    const float* pb = part + (size_t)(seq < 2 ? (seq * 8 + head) * 32 : 512 + ((seq - 2) * 8 + head) * 4) * PART_STRIDE;
    float M = -3.0e38f;
    for (int s2 = 0; s2 < NS; ++s2) M = fmaxf(M, pb[(size_t)s2 * PART_STRIDE + 2048 + row]);
    float num = 0.f, den = 0.f;
    for (int s2 = 0; s2 < NS; ++s2) {
      const float* q = pb + (size_t)s2 * PART_STRIDE;
      const float w = __builtin_amdgcn_exp2f((q[2048 + row] - M) * C);
      num += w * q[row * 128 + col]; den += w * q[2064 + row];
    }
    o[(size_t)(META0 + 64 * seq + 48 + row) * 1024 + head * 128 + col] = f2bf(num / den);
  }
}

#define XB_TMO      128
#define XB_XCNT(j)  (256  + 64 * (j))
#define XB_XSUB(j)  (1280 + 64 * (j))
#define XB_XGEN(j)  (2304 + 64 * (j))
#define XB_TOP      3328
#define XB_TOPGEN   3392
#define XCD_BAR_WORDS 3456
#define XB_SPIN_CAP (1u << 18)
#define LAS __attribute__((address_space(3)))

__device__ __forceinline__ unsigned xb_ld(unsigned* p)              { return __hip_atomic_load(p, __ATOMIC_RELAXED, __HIP_MEMORY_SCOPE_AGENT); }
__device__ __forceinline__ unsigned xb_add(unsigned* p, unsigned v) { return __hip_atomic_fetch_add(p, v, __ATOMIC_RELAXED, __HIP_MEMORY_SCOPE_AGENT); }
__device__ __forceinline__ unsigned xb_xcc_id() { return (unsigned)__builtin_amdgcn_s_getreg((3 << 11) | 20) & 0xFu; }
#define XB_SPIN(cond, bar) do { unsigned _sp = 0; while (cond) { __builtin_amdgcn_s_sleep(1); \
    if ((++_sp & 255u) == 0u) { if (xb_ld(&(bar)[XB_TMO])) break; if (_sp > XB_SPIN_CAP) { atomicAdd(&(bar)[XB_TMO], 1u); break; } } } } while (0)

struct XcdBarrier {
    unsigned* bar; unsigned x;
    volatile LAS unsigned* st;
};

__device__ __forceinline__ XcdBarrier xcd_barrier_post(unsigned* bar, volatile LAS unsigned* st) {
    XcdBarrier b; b.bar = bar; b.x = xb_xcc_id(); b.st = st;
    if (__builtin_amdgcn_workitem_id_x() == 0) (void)xb_add(&bar[XB_XCNT(b.x)], 1u);
    return b;
}
__device__ __forceinline__ void xcd_barrier_complete(unsigned* bar, unsigned x, unsigned& nloc, unsigned& nx) {
    const unsigned G = gridDim.x * gridDim.y * gridDim.z;
    unsigned sum, cnt, mine, sp = 0u;
    for (;;) {
        sum = 0u; cnt = 0u; mine = 0u;
#pragma unroll
        for (unsigned j = 0; j < 16; ++j) { const unsigned c = xb_ld(&bar[XB_XCNT(j)]); sum += c; cnt += (c > 0u) ? 1u : 0u; mine = (j == x) ? c : mine; }
        if (sum == G) break;
        __builtin_amdgcn_s_sleep(1);
        if ((++sp & 255u) == 0u) { if (xb_ld(&bar[XB_TMO])) break; if (sp > XB_SPIN_CAP) { atomicAdd(&bar[XB_TMO], 1u); break; } }
    }
    nloc = mine > 0u ? mine : 1u; nx = cnt > 0u ? cnt : 1u;
}

__device__ __forceinline__ void xcd_barrier(const XcdBarrier& b) {
    asm volatile("s_waitcnt vmcnt(0)" ::: "memory");
    __syncthreads();
    if (__builtin_amdgcn_workitem_id_x() == 0) {
        unsigned* bar = b.bar;
        __builtin_amdgcn_s_waitcnt(0);
        unsigned nloc = b.st[0], nx = b.st[1];
        if (nloc == 0u) { xcd_barrier_complete(bar, b.x, nloc, nx); b.st[0] = nloc; b.st[1] = nx; }
        const unsigned old = xb_add(&bar[XB_XSUB(b.x)], 1u);
        const unsigned gen = old / nloc;
        if (old + 1u == (gen + 1u) * nloc) {
            __builtin_amdgcn_fence(__ATOMIC_RELEASE, "agent");
            asm volatile("s_waitcnt vmcnt(0)" ::: "memory");
            const unsigned og = xb_add(&bar[XB_TOP], 1u);
            const unsigned tg = og / nx;
            if (og + 1u == (tg + 1u) * nx) xb_add(&bar[XB_TOPGEN], 1u);
            else XB_SPIN(xb_ld(&bar[XB_TOPGEN]) == tg, bar);
            __builtin_amdgcn_fence(__ATOMIC_ACQUIRE, "agent");
            xb_add(&bar[XB_XGEN(b.x)], 1u);
            asm volatile("s_waitcnt vmcnt(0)" ::: "memory");
        } else {
            XB_SPIN(xb_ld(&bar[XB_XGEN(b.x)]) == gen, bar);
            __builtin_amdgcn_fence(__ATOMIC_ACQUIRE, "agent");
            asm volatile("s_waitcnt vmcnt(0)" ::: "memory");
        }
    }
    __syncthreads();
}


DEVI void run_group(const Params& p, int gi, char* lds) {
  char* ar = p.ws + O_ARENA;
  if (gi == 36) { phase_final_norm(p); return; }
  const int L = gi >= 18 ? 1 : 0, st = gi - 18 * L;
  switch (st) {
    case 0:
      phase_convert(p, L, lds);
      phase_s5prep1(p, L);
      if (L == 0) phase_rope_table(p);
      phase_norm(p, p.norm_mix + L * 1024, (bf16_t*)(ar + A_XN1), L == 0);
      break;
    case 1: phase_s5prep2(p, L); phase_proj(p, lds); break;
    case 2: phase_s5prep3(p, L); phase_latent_rstd(p); phase_s5a1(p, lds); break;
    case 3: phase_carry(p); break;
    case 4: phase_s5a3(p, lds); break;
    case 5: phase_glu(p, L, lds); break;
    case 6: case 8: case 10: phase_qkv(p, (st - 6) >> 1, lds); break;
    case 7: case 9: case 11: phase_attn(p, (st - 7) >> 1, lds); break;
    case 12: phase_attn_combine(p); phase_norm(p, p.norm_mix + L * 1024, (bf16_t*)(ar + A_XN2), L == 0); break;
    case 13: phase_merge(p, lds); break;
    case 14: phase_resid_gemm(p, (const bf16_t*)(ar + A_MERGED), 1024, (const bf16_t*)(p.ws + O_WMIX), L == 0, lds); break;
    case 15: phase_norm(p, p.norm_ffn + L * 1024, (bf16_t*)(ar + A_XN3), false, LDX); break;
    case 16: phase_ffn_up(p, lds); break;
    default: phase_resid_gemm(p, (const bf16_t*)(ar + A_HID), 2816, (const bf16_t*)(p.ws + O_WD), false, lds); break;
  }
}


#ifndef DBG_GROUPS
#define DBG_GROUPS 0
#endif
#ifndef DBG_OFF
#define DBG_OFF 0
#endif
#ifndef DBG_N
#define DBG_N 1
#endif
__global__ __launch_bounds__(512) void dbg_dump_kernel(Params p, size_t off, unsigned n) {
  const bf16_t* b = (const bf16_t*)(p.ws + off);
  for (size_t i = (size_t)blockIdx.x * 512 + threadIdx.x; i < (size_t)NREAL * 1024; i += (size_t)gridDim.x * 512)
    p.out[i] = bf2f(b[(unsigned)i % n]);
}
#ifndef MULTI_LAUNCH
#define MULTI_LAUNCH 0
#endif

__global__ __launch_bounds__(512, 1) void mega_fwd(Params p, int g_begin, int g_end) {
  extern __shared__ __attribute__((aligned(16))) char lds[];
  volatile LAS unsigned* xst = (volatile LAS unsigned*)(LAS char*)(lds + LDS_BYTES - 16);
  if (__builtin_amdgcn_workitem_id_x() == 0) { xst[0] = 0u; xst[1] = 0u; }
  __syncthreads();
  const XcdBarrier xb = xcd_barrier_post((unsigned*)(p.ws + O_BAR), xst);
#pragma unroll 1
  for (int gi = g_begin; gi < g_end; ++gi) {
    run_group(p, gi, lds);
    if (gi + 1 < g_end) {
      if (gi == g_begin) { asm volatile("s_waitcnt vmcnt(0) lgkmcnt(0)" ::: "memory"); cg::this_grid().sync(); }
      else xcd_barrier(xb);
    }
  }
}

extern "C" void kernel_launch(void* const* d_in, const int* in_sizes, int n_in, void* d_out, int out_size, void* d_ws, size_t ws_size,
                              hipStream_t stream) {
  static int grid_blocks = 0;
  if (!grid_blocks) {
    if (ws_size < WS_NEED) { fprintf(stderr, "kernel_launch: workspace too small: %zu < %zu\n", ws_size, (size_t)WS_NEED); return; }
    if (hipFuncSetAttribute((const void*)mega_fwd, hipFuncAttributeMaxDynamicSharedMemorySize, LDS_BYTES) != hipSuccess) {
      fprintf(stderr, "kernel_launch: hipFuncSetAttribute failed\n"); return; }
    int dev = 0, cus = 0, per_cu = 0;
    hipGetDevice(&dev);
    hipDeviceGetAttribute(&cus, hipDeviceAttributeMultiprocessorCount, dev);
    hipOccupancyMaxActiveBlocksPerMultiprocessor(&per_cu, mega_fwd, 512, LDS_BYTES);
    if (per_cu < 1) { fprintf(stderr, "kernel_launch: occupancy query returned %d\n", per_cu); return; }
    grid_blocks = cus;
  }
  Params p{};
  const float** f = (const float**)&p;
  for (int i = 0; i < 27; ++i) f[i] = (const float*)d_in[i];
  p.out = (float*)d_out; p.ws = (char*)d_ws;
  for (int i = 0; i < 32; ++i) { const float pw = (float)pow(10000.0, (double)i / 32.0); p.inv[i] = 1.0f / pw; }
  int gb = 0, ge = 37;
  if (MULTI_LAUNCH) {
    const int ng = DBG_GROUPS > 0 ? DBG_GROUPS : 37;
    for (int g = 0; g < ng; ++g) hipLaunchKernelGGL(mega_fwd, dim3(grid_blocks), dim3(512), LDS_BYTES, stream, p, g, g + 1);
    if (DBG_GROUPS > 0) hipLaunchKernelGGL(dbg_dump_kernel, dim3(2048), dim3(512), 0, stream, p, (size_t)(DBG_OFF), (unsigned)(DBG_N));
    return;
  }
  hipMemsetAsync((char*)d_ws + O_BAR, 0, 4096 * 4, stream);
  void* args[] = {&p, &gb, &ge};
  hipError_t e = hipLaunchCooperativeKernel((const void*)mega_fwd, dim3(grid_blocks), dim3(512), args, LDS_BYTES, stream);
  if (e != hipSuccess) fprintf(stderr, "cooperative launch failed: %s (grid %d)\n", hipGetErrorString(e), grid_blocks);
}
```

```cpp
#include <hip/hip_runtime.h>
#include <hip/hip_cooperative_groups.h>
#include <cstdio>
#include <cstdint>
#include <cmath>
namespace cg = cooperative_groups;

typedef unsigned short bf16_t;
typedef short bf16x8 __attribute__((ext_vector_type(8)));
typedef short s16x4 __attribute__((ext_vector_type(4)));
typedef float f32x16 __attribute__((ext_vector_type(16)));
typedef float f32x4 __attribute__((ext_vector_type(4)));
typedef unsigned u32x4 __attribute__((ext_vector_type(4)));
typedef unsigned u32x2 __attribute__((ext_vector_type(2)));
#define DEVI __device__ __forceinline__
#define SBAR() __builtin_amdgcn_sched_barrier(0)

constexpr int NREAL = 49152, META0 = 49152, MPAD = 49920, NTILE_M = 195;
constexpr int NCHUNK = 1560, NCHUNK_PAD = 1792;
constexpr int QG_ROWS = 16896;
constexpr int LDS_BYTES = 150528;

struct Params {
  const float* x_prompt; const float* x_sample; const float* meta; const float* norm_mix; const float* w_in;
  const float* lam_re; const float* lam_im; const float* log_dt; const float* b_re; const float* b_im; const float* c_re; const float* c_im;
  const float* ssm_d; const float* w_glu; const float* b_glu; const float* w_ssm_out; const float* norm_cq; const float* w_uq;
  const float* norm_ckv; const float* w_ukv; const float* w_attn_out; const float* w_mix_out; const float* norm_ffn;
  const float* w_ffn_gate; const float* w_ffn_up; const float* w_ffn_down; const float* norm_final;
  float* out; char* ws;
  float inv[32];
};

constexpr size_t al(size_t x) { return (x + 255) & ~size_t(255); }
constexpr size_t O_WIN = 0;
constexpr size_t O_WG = O_WIN + al((size_t)1280 * 1024 * 2);
constexpr size_t O_WGLU = O_WG + al((size_t)2048 * 1024 * 2);
constexpr size_t O_WSSM = O_WGLU + al((size_t)512 * 512 * 2);
constexpr size_t O_WUQ = O_WSSM + al((size_t)1024 * 512 * 2);
constexpr size_t O_WUKV = O_WUQ + al((size_t)1536 * 384 * 2);
constexpr size_t O_WATTN = O_WUKV + al((size_t)2048 * 256 * 2);
constexpr size_t O_WMIX = O_WATTN + al((size_t)1024 * 1024 * 2);
constexpr size_t O_WGU = O_WMIX + al((size_t)1024 * 1024 * 2);
constexpr int LDX = 1088;
constexpr size_t O_WD = O_WGU + al((size_t)5632 * LDX * 2);
constexpr size_t O_APOW = O_WD + al((size_t)1024 * 2816 * 2);
constexpr size_t O_BBAR = O_APOW + al((size_t)2 * 32 * 33 * 64 * 8);
constexpr size_t O_KFB = O_BBAR + al((size_t)2 * 32 * 64 * 16 * 8);
constexpr size_t O_W1T = O_KFB + al((size_t)2 * 32 * 32 * 256 * 4);
constexpr size_t O_W3T = O_W1T + al((size_t)32 * 256 * 512 * 2);
constexpr size_t O_ROPE = O_W3T + al((size_t)32 * 512 * 768 * 2);
constexpr size_t O_HMETA = O_ROPE + al((size_t)16400 * 32 * 8);
constexpr size_t O_BAR = O_HMETA + al((size_t)768 * 1024 * 4);
constexpr size_t O_RSTD = O_BAR + al((size_t)4096 * 4);
constexpr size_t O_ARENA = O_RSTD + al((size_t)49920 * 2 * 4);
constexpr size_t A_Z2 = 0;
constexpr size_t A_CARRY = 0;
constexpr size_t A_O = 51118080;
constexpr size_t A_XN1 = A_O;
constexpr size_t A_QG = 153354240;
constexpr size_t A_U = A_QG;
constexpr size_t A_KVG = 205258752;
constexpr size_t A_SLOC = A_KVG;
constexpr size_t A_Z1 = A_KVG;
constexpr size_t A_CQ = 274464768;
constexpr size_t A_CKV = 312803328;
constexpr size_t A_KR = 338362368;
constexpr size_t A_XN2 = A_QG;
constexpr size_t A_MERGED = 255590400;
constexpr size_t A_XN3 = 0;
constexpr size_t A_HID = 108625920;
constexpr size_t ARENA_SIZE = 389775360;
constexpr size_t WS_NEED = O_ARENA + ARENA_SIZE;

DEVI int otid() { int t = __builtin_amdgcn_workitem_id_x(); asm volatile("" : "+v"(t)); return t; }
DEVI bf16_t f2bf(float f) { unsigned u = __float_as_uint(f); u += 0x7fffu + ((u >> 16) & 1u); return (bf16_t)(u >> 16); }
DEVI float bf2f(bf16_t b) { return __uint_as_float(((unsigned)b) << 16); }
typedef __bf16 bf16x2_t __attribute__((ext_vector_type(2)));
DEVI unsigned cvtpk(float lo, float hi) { bf16x2_t v; v[0] = (__bf16)lo; v[1] = (__bf16)hi; return __builtin_bit_cast(unsigned, v); }
DEVI int crow(int r, int hi) { return (r & 3) + 8 * (r >> 2) + 4 * hi; }
DEVI float sigmoidf_(float x) { return __builtin_amdgcn_rcpf(1.f + __expf(-x)); }
DEVI int pos_of_row(int m) {
  if (m < 32768) return (m & 16383) + 16;
  if (m < NREAL) return ((m - 32768) & 2047) + 16;
  int lr = (m - META0) & 63; return lr >= 48 ? lr - 48 : 0;
}
DEVI f32x4 unpack4(u32x2 w) { f32x4 v; v[0] = __uint_as_float(w.x << 16); v[1] = __uint_as_float(w.x & 0xffff0000u); v[2] = __uint_as_float(w.y << 16); v[3] = __uint_as_float(w.y & 0xffff0000u); return v; }
DEVI bool is_pad_lr(int lr) { return lr >= 640 || (lr & 63) < 48; }
template <int MI> DEVI void zero_acc(f32x16 (&acc)[MI][2]) {
#pragma unroll
  for (int mi = 0; mi < MI; ++mi)
#pragma unroll
    for (int ni = 0; ni < 2; ++ni)
#pragma unroll
      for (int r = 0; r < 16; ++r) acc[mi][ni][r] = 0.f;
}
#define FOR_MN(mi, ni) _Pragma("unroll") for (int mi = 0; mi < MIV; ++mi) _Pragma("unroll") for (int ni = 0; ni < 2; ++ni)
#define FOR_R(r) _Pragma("unroll") for (int r = 0; r < 16; ++r)
#define FOR_ACC(mi, ni, r) _Pragma("unroll") for (int mi = 0; mi < MIV; ++mi) _Pragma("unroll") for (int ni = 0; ni < 2; ++ni) _Pragma("unroll") for (int r = 0; r < 16; ++r)

template <int MI> struct GStage { u32x4 ra0[MI], rb0[4], ra1[MI], rb1[4]; };
#define GEMM_ADDR()                                                                                                                 \
  const int tid = otid(), lane = tid & 63, wid = tid >> 6, r32 = lane & 31, hi = lane >> 5;                                        \
  const int wm = wid >> 2, wn = wid & 3;                                                                                            \
  const int lrow = tid >> 3, lslot = tid & 7;                                                                                       \
  unsigned aoff[MI];                                                                                                                \
  _Pragma("unroll") for (int i = 0; i < MI; ++i) { int r = lrow + 64 * i; r = r < arows ? r : arows - 1; aoff[i] = (unsigned)(r * lda) * 2u; }  \
  const unsigned boff = (unsigned)(lrow * ldb + lslot * 8) * 2u;                                                                    \
  const int pmask = (1 << pl) - 1;                                                                                                  \
  const int nk = K >> 6;
#define GLOAD(RA, RB, kt_) do { const int k_ = (kt_) * 64 + lslot * 8; const unsigned ko_ = (unsigned)(((k_ >> pl) * ps) + (k_ & pmask)) * 2u;  \
    _Pragma("unroll") for (int i = 0; i < MI; ++i) RA[i] = *(const u32x4*)((const char*)A + (aoff[i] + ko_));                       \
    _Pragma("unroll") for (int i = 0; i < 4; ++i) RB[i] = *(const u32x4*)((const char*)B + (boff + (unsigned)(64 * i * ldb + (kt_) * 64) * 2u)); } while (0)

template <int MI, int PF = 1>
DEVI void gemm_prefetch(GStage<MI>& st, const bf16_t* __restrict__ A, int lda, int arows, int pl, int ps,
                        const bf16_t* __restrict__ B, int ldb, int K) {
  GEMM_ADDR();
  (void)hi; (void)wm; (void)wn; (void)r32;
  GLOAD(st.ra0, st.rb0, 0);
  if constexpr (PF == 2) { if (nk > 1) GLOAD(st.ra1, st.rb1, 1); }
}

template <int MI, int PF = 1, int KSBT = 0>
DEVI void gemm_main(f32x16 (&acc)[MI][2], GStage<MI>& st, const bf16_t* __restrict__ A, int lda, int arows, int pl, int ps,
                    const bf16_t* __restrict__ B, int ldb, int K, char* lds) {
  GEMM_ADDR();
  const int wofs = lrow * 128 + ((lslot ^ ((lrow >> 1) & 7)) << 4);
#define LWRITE(b_, RA, RB) do { char* As_ = lds + (b_) * 32768 + wofs; char* Bs_ = lds + 65536 + (b_) * 32768 + wofs;            \
    _Pragma("unroll") for (int i = 0; i < MI; ++i) *(u32x4*)(As_ + i * 8192) = RA[i];                                              \
    _Pragma("unroll") for (int i = 0; i < 4; ++i) *(u32x4*)(Bs_ + i * 8192) = RB[i]; } while (0)
  const int swz = (r32 >> 1) & 7;
  const int abase = (wm * (32 * MI) + r32) * 128, bbase = 65536 + (wn * 64 + r32) * 128;
  constexpr int KSB = KSBT ? KSBT : (MI == 2 ? 2 : 1);
  constexpr int MHF = MI == 4 ? 2 : MI;
#define COMPUTE(b_) do { const char* Ab_ = lds + (b_) * 32768 + abase; const char* Bb_ = lds + (b_) * 32768 + bbase;              \
    _Pragma("unroll") for (int kb = 0; kb < 4; kb += KSB) _Pragma("unroll") for (int mh = 0; mh < MI; mh += MHF) {                 \
      bf16x8 fa_[KSB][MHF], fb_[KSB][2];                                                                                           \
      _Pragma("unroll") for (int k2 = 0; k2 < KSB; ++k2) { const int so = (((kb + k2) * 2 + hi) ^ swz) << 4;                       \
        _Pragma("unroll") for (int mi = 0; mi < MHF; ++mi) fa_[k2][mi] = *(const bf16x8*)(Ab_ + (mh + mi) * 4096 + so);            \
        _Pragma("unroll") for (int ni = 0; ni < 2; ++ni) fb_[k2][ni] = *(const bf16x8*)(Bb_ + ni * 4096 + so); }                   \
      SBAR();                                                                                                                      \
      _Pragma("unroll") for (int k2 = 0; k2 < KSB; ++k2) _Pragma("unroll") for (int mi = 0; mi < MHF; ++mi)                        \
        _Pragma("unroll") for (int ni = 0; ni < 2; ++ni)                                                                           \
          acc[mh + mi][ni] = __builtin_amdgcn_mfma_f32_32x32x16_bf16(fa_[k2][mi], fb_[k2][ni], acc[mh + mi][ni], 0, 0, 0);         \
      SBAR(); } } while (0)
  if constexpr (PF == 2) {
    __syncthreads(); LWRITE(0, st.ra0, st.rb0); __syncthreads();
#pragma unroll 1
    for (int kt = 0; kt < nk; kt += 2) {
      if (kt + 2 < nk) GLOAD(st.ra0, st.rb0, kt + 2);
      COMPUTE(0);
      if (kt + 1 < nk) LWRITE(1, st.ra1, st.rb1);
      __syncthreads();
      if (kt + 1 >= nk) break;
      if (kt + 3 < nk) GLOAD(st.ra1, st.rb1, kt + 3);
      COMPUTE(1);
      if (kt + 2 < nk) LWRITE(0, st.ra0, st.rb0);
      __syncthreads();
    }
  } else {
    __syncthreads(); LWRITE(0, st.ra0, st.rb0);
    if (nk > 1) GLOAD(st.ra0, st.rb0, 1);
    __syncthreads();
#pragma unroll 1
    for (int kt = 0; kt < nk; ++kt) {
      const int b = kt & 1;
      if (kt + 1 < nk) {
        LWRITE(b ^ 1, st.ra0, st.rb0);
        if (kt + 2 < nk) GLOAD(st.ra0, st.rb0, kt + 2);
      }
      COMPUTE(b);
      __syncthreads();
    }
  }
#undef LWRITE
#undef COMPUTE
}

template <int MI, int PF = 1>
DEVI void gemm_acc(f32x16 (&acc)[MI][2], const bf16_t* __restrict__ A, int lda, int arows, int pl, int ps,
                   const bf16_t* __restrict__ B, int ldb, int K, char* lds) {
  GStage<MI> st;
  gemm_prefetch<MI, PF>(st, A, lda, arows, pl, ps, B, ldb, K);
  gemm_main<MI, PF, (MI == 2 ? 4 : 0)>(acc, st, A, lda, arows, pl, ps, B, ldb, K, lds);
}

DEVI bool unit_xcd(int i, int nM, int nN, int& mt, int& nt) {
  const int x = blockIdx.x & 7, lb = blockIdx.x >> 3, nb = gridDim.x >> 3;
  const int m0 = (x * nM) >> 3, m1 = ((x + 1) * nM) >> 3;
  const int li = lb + nb * i;
  if (li >= (m1 - m0) * nN) return false;
  mt = m0 + li / nN; nt = li % nN; return true;
}

DEVI bool unit_xcd_cb(int i, int nM, int nN, int CB, int& mt, int& nt) {
  const int x = blockIdx.x & 7, lb = blockIdx.x >> 3, nb = gridDim.x >> 3;
  const int m0 = (x * nM) >> 3, m1 = ((x + 1) * nM) >> 3, Mx = m1 - m0;
  const int li = lb + nb * i;
  const int nbk = nN / CB, rem = nN - nbk * CB, full = nbk * CB * Mx;
  if (li < full) { const int b = li / (CB * Mx), r = li - b * (CB * Mx); mt = m0 + r / CB; nt = b * CB + r % CB; return true; }
  const int l2 = li - full;
  if (rem == 0 || l2 >= rem * Mx) return false;
  mt = m0 + l2 / rem; nt = nbk * CB + l2 % rem; return true;
}

DEVI void conv_job(const float* __restrict__ src, int K, int N, int ncol0, int ncols, bf16_t* __restrict__ dst, int mode,
                   const float* __restrict__ kscale, int wgid, int nwaves, char* ldsw, int& joff, int dld = 0) {
  if (dld == 0) dld = K;
  const int ntn = ncols >> 6, ntk = K >> 6, lane = otid() & 63;
  bf16_t* t = (bf16_t*)ldsw;
  int start = wgid - (joff % nwaves); if (start < 0) start += nwaves;
  for (int ti = start; ti < ntn * ntk; ti += nwaves) {
    const int tn = ti % ntn, tk = ti / ntn, n0 = tn * 64, k0 = tk * 64;
#pragma unroll 16
    for (int i = 0; i < 64; ++i) {
      float v = src[(long)(k0 + i) * N + ncol0 + n0 + lane];
      if (kscale) v *= kscale[k0 + i];
      t[lane * 66 + i] = f2bf(v);
    }
    __builtin_amdgcn_wave_barrier();
    asm volatile("s_waitcnt lgkmcnt(0)" ::: "memory");
    for (int it = 0; it < 32; ++it) {
      const int row = it * 2 + (lane >> 5), c2 = (lane & 31) * 2;
      const unsigned v = *(const unsigned*)&t[row * 66 + c2];
      const int n = n0 + row;
      const int orow = mode == 0 ? n : ((n >> 5) * 64 + (n & 31) + (mode == 2 ? 32 : 0));
      *(unsigned*)&dst[(long)orow * dld + k0 + c2] = v;
    }
    __builtin_amdgcn_wave_barrier();
    asm volatile("s_waitcnt lgkmcnt(0)" ::: "memory");
  }
  joff += ntn * ntk;
}

DEVI void phase_convert(const Params& p, int L, char* lds) {
  char* ws = p.ws;
  const int wgid = blockIdx.x * 8 + (otid() >> 6), nwaves = gridDim.x * 8;
  char* ldsw = lds + (otid() >> 6) * 8448;
  int joff = 0;
  conv_job(p.w_in + (size_t)L * 1024 * 3264, 1024, 3264, 0, 1216, (bf16_t*)(ws + O_WIN), 0, nullptr, wgid, nwaves, ldsw, joff);
  conv_job(p.w_in + (size_t)L * 1024 * 3264, 1024, 3264, 1216, 2048, (bf16_t*)(ws + O_WG), 0, nullptr, wgid, nwaves, ldsw, joff);
  conv_job(p.w_glu + (size_t)L * 512 * 512, 512, 512, 0, 512, (bf16_t*)(ws + O_WGLU), 0, nullptr, wgid, nwaves, ldsw, joff);
  conv_job(p.w_ssm_out + (size_t)L * 512 * 1024, 512, 1024, 0, 1024, (bf16_t*)(ws + O_WSSM), 0, nullptr, wgid, nwaves, ldsw, joff);
  conv_job(p.w_uq + (size_t)L * 384 * 1536, 384, 1536, 0, 1536, (bf16_t*)(ws + O_WUQ), 0, p.norm_cq + L * 384, wgid, nwaves, ldsw, joff);
  conv_job(p.w_ukv + (size_t)L * 256 * 2048, 256, 2048, 0, 2048, (bf16_t*)(ws + O_WUKV), 0, p.norm_ckv + L * 256, wgid, nwaves, ldsw, joff);
  conv_job(p.w_attn_out + (size_t)L * 1024 * 1024, 1024, 1024, 0, 1024, (bf16_t*)(ws + O_WATTN), 0, nullptr, wgid, nwaves, ldsw, joff);
  conv_job(p.w_mix_out + (size_t)L * 1024 * 1024, 1024, 1024, 0, 1024, (bf16_t*)(ws + O_WMIX), 0, nullptr, wgid, nwaves, ldsw, joff);
  conv_job(p.w_ffn_gate + (size_t)L * 1024 * 2816, 1024, 2816, 0, 2816, (bf16_t*)(ws + O_WGU), 1, nullptr, wgid, nwaves, ldsw, joff, LDX);
  conv_job(p.w_ffn_up + (size_t)L * 1024 * 2816, 1024, 2816, 0, 2816, (bf16_t*)(ws + O_WGU), 2, nullptr, wgid, nwaves, ldsw, joff, LDX);
  conv_job(p.w_ffn_down + (size_t)L * 2816 * 1024, 2816, 1024, 0, 1024, (bf16_t*)(ws + O_WD), 0, nullptr, wgid, nwaves, ldsw, joff);
  unsigned* z = (unsigned*)(ws + O_WIN + (size_t)1216 * 1024 * 2);
  const int zt = otid();
#pragma unroll 1
  for (int b = blockIdx.x; b < 64; b += gridDim.x) z[b * 512 + zt] = 0u;
}

DEVI void sincos_rev(double ang, float& c, float& s) {
  double t = ang * 0.15915494309189535; t -= rint(t);
  const float tf = (float)t;
  c = __builtin_amdgcn_cosf(tf); s = __builtin_amdgcn_sinf(tf);
}

DEVI void phase_s5prep1(const Params& p, int L) {
  char* ws = p.ws;
  float2* Apow = (float2*)(ws + O_APOW); float2* Bbar = (float2*)(ws + O_BBAR);
  const int gtid = blockIdx.x * 512 + otid(), nthr = gridDim.x * 512;
  for (int idx = gtid; idx < 4096; idx += nthr) {
    const int pp = idx & 63, g = (idx >> 6) & 31, dir = idx >> 11;
    const int pg = (L * 2 + dir) * 32 + g;
    const float lr = p.lam_re[pg * 64 + pp], li = p.lam_im[pg * 64 + pp];
    const float dt = expf(p.log_dt[pg]);
    float ar = 1.f, ai = 0.f;
    for (int d = 0; d <= 32; ++d) {
      float c, s; sincos_rev((double)li * (double)dt * (double)d, c, s);
      const float mag = expf(lr * dt * (float)d);
      Apow[((dir * 32 + g) * 33 + d) * 64 + pp] = make_float2(mag * c, mag * s);
      if (d == 1) { ar = mag * c; ai = mag * s; }
    }
    const float nr = ar - 1.f, den = lr * lr + li * li;
    const float sr = (nr * lr + ai * li) / den, si = (ai * lr - nr * li) / den;
    for (int h = 0; h < 16; ++h) {
      const float br = p.b_re[(size_t)(pg * 64 + pp) * 16 + h], bi = p.b_im[(size_t)(pg * 64 + pp) * 16 + h];
      Bbar[((dir * 32 + g) * 64 + pp) * 16 + h] = make_float2(sr * br - si * bi, sr * bi + si * br);
    }
  }
}

DEVI void phase_s5prep2(const Params& p, int L) {
  char* ws = p.ws;
  const float2* Apow = (const float2*)(ws + O_APOW); const float2* Bbar = (const float2*)(ws + O_BBAR);
  float* KFB = (float*)(ws + O_KFB); bf16_t* W1T = (bf16_t*)(ws + O_W1T); bf16_t* W3T = (bf16_t*)(ws + O_W3T);
  const int gtid = blockIdx.x * 512 + otid(), nthr = gridDim.x * 512;
  for (int idx = gtid; idx < 2 * 32 * 32 * 256; idx += nthr) {
    const int hh = idx & 255, h = hh >> 4, h2 = hh & 15, d = (idx >> 8) & 31, g = (idx >> 13) & 31, dir = idx >> 18;
    const int pg = (L * 2 + dir) * 32 + g;
    const float* cr = p.c_re + (size_t)(pg * 16 + h) * 64; const float* ci = p.c_im + (size_t)(pg * 16 + h) * 64;
    const float2* A = Apow + ((dir * 32 + g) * 33 + d) * 64; const float2* Bb = Bbar + ((dir * 32 + g) * 64) * 16 + h2;
    float val = 0.f;
    for (int pp = 0; pp < 64; ++pp) {
      const float2 a = A[pp], b = Bb[pp * 16];
      const float tr = cr[pp] * a.x - ci[pp] * a.y, ti = cr[pp] * a.y + ci[pp] * a.x;
      val += tr * b.x - ti * b.y;
    }
    KFB[idx] = val;
  }
  for (int idx = gtid; idx < 32 * 256 * 512; idx += nthr) {
    const int k = idx & 511, n = (idx >> 9) & 255, g = idx >> 17;
    const int dir = n >> 7, reim = (n >> 6) & 1, pp = n & 63, j = k >> 4, h2 = k & 15;
    const int e = dir == 0 ? 31 - j : j;
    const float2 a = Apow[((dir * 32 + g) * 33 + e) * 64 + pp], b = Bbar[((dir * 32 + g) * 64 + pp) * 16 + h2];
    const float vr = a.x * b.x - a.y * b.y, vi = a.x * b.y + a.y * b.x;
    W1T[idx] = f2bf(reim ? vi : vr);
  }
  for (int idx = gtid; idx < 32 * 512 * 256; idx += nthr) {
    const int kk = idx & 255, n = (idx >> 8) & 511, g = idx >> 17;
    const int dir = kk >> 7, reim = (kk >> 6) & 1, pp = kk & 63, j = n >> 4, h = n & 15;
    const int e = dir == 0 ? j + 1 : 32 - j;
    const int pg = (L * 2 + dir) * 32 + g;
    const float cr = p.c_re[(size_t)(pg * 16 + h) * 64 + pp], ci = p.c_im[(size_t)(pg * 16 + h) * 64 + pp];
    const float2 a = Apow[((dir * 32 + g) * 33 + e) * 64 + pp];
    const float vr = cr * a.x - ci * a.y, vi = cr * a.y + ci * a.x;
    W3T[(size_t)(g * 512 + n) * 768 + 512 + kk] = f2bf(reim ? -vi : vr);
  }
}

DEVI void phase_s5prep3(const Params& p, int L) {
  char* ws = p.ws;
  const float* KFB = (const float*)(ws + O_KFB); bf16_t* W3T = (bf16_t*)(ws + O_W3T);
  const int gtid = blockIdx.x * 512 + otid(), nthr = gridDim.x * 512;
  for (int idx = gtid; idx < 32 * 512 * 512; idx += nthr) {
    const int k = idx & 511, n = (idx >> 9) & 511, g = idx >> 18;
    const int s = k >> 4, h2 = k & 15, j = n >> 4, h = n & 15;
    float val = 0.f;
    if (s <= j) val += KFB[((0 * 32 + g) * 32 + (j - s)) * 256 + h * 16 + h2];
    if (s >= j) val += KFB[((1 * 32 + g) * 32 + (s - j)) * 256 + h * 16 + h2];
    if (s == j && h == h2) val += p.ssm_d[L * 512 + g * 16 + h];
    W3T[(size_t)(g * 512 + n) * 768 + k] = f2bf(val);
  }
}

DEVI void phase_rope_table(const Params& p) {
  float2* rope = (float2*)(p.ws + O_ROPE);
  const int gtid = blockIdx.x * 512 + otid(), nthr = gridDim.x * 512;
  for (int idx = gtid; idx < 16400 * 32; idx += nthr) {
    const int i = idx & 31, pos = idx >> 5;
    const float ang = (float)pos * p.inv[i];
    float c, s; sincos_rev((double)ang, c, s);
    rope[idx] = make_float2(c, s);
  }
}

DEVI const float* hrow_c(const Params& p, int m) { return m < NREAL ? p.out + (size_t)m * 1024 : (const float*)(p.ws + O_HMETA) + (size_t)(m - META0) * 1024; }

DEVI void phase_norm(const Params& p, const float* __restrict__ gain, bf16_t* __restrict__ xn, bool from_input, int ld = 1024) {
  const int lane = otid() & 63;
  const int wgid = blockIdx.x * 8 + (otid() >> 6), nwaves = gridDim.x * 8;
  f32x4 g4[4];
#pragma unroll
  for (int i = 0; i < 4; ++i) g4[i] = *(const f32x4*)(gain + i * 256 + lane * 4);
  for (int m0 = wgid; m0 < MPAD; m0 += 2 * nwaves) {
    f32x4 v[2][4]; bool val[2];
#pragma unroll
    for (int j = 0; j < 2; ++j) {
      const int m = m0 + j * nwaves; val[j] = m < MPAD;
      const float* src = nullptr; bool zero = !val[j];
      if (val[j]) {
        if (from_input) {
          if (m < 32768) src = p.x_prompt + (size_t)m * 1024;
          else if (m < NREAL) src = p.x_sample + (size_t)(m - 32768) * 1024;
          else { const int lr = m - META0; if (is_pad_lr(lr)) zero = true; else src = p.meta + (size_t)((lr & 63) - 48) * 1024; }
        } else src = hrow_c(p, m);
      }
#pragma unroll
      for (int i = 0; i < 4; ++i) { if (zero) v[j][i] = (f32x4){0.f, 0.f, 0.f, 0.f}; else v[j][i] = *(const f32x4*)(src + i * 256 + lane * 4); }
    }
#pragma unroll
    for (int j = 0; j < 2; ++j) {
      if (!val[j]) continue;
      const int m = m0 + j * nwaves;
      float ss = 0.f;
#pragma unroll
      for (int i = 0; i < 4; ++i) ss += v[j][i][0] * v[j][i][0] + v[j][i][1] * v[j][i][1] + v[j][i][2] * v[j][i][2] + v[j][i][3] * v[j][i][3];
#pragma unroll
      for (int o = 32; o >= 1; o >>= 1) ss += __shfl_xor(ss, o);
      const float rstd = rsqrtf(ss * (1.f / 1024.f) + 1e-6f);
#pragma unroll
      for (int i = 0; i < 4; ++i) {
        u32x2 w; w.x = cvtpk(v[j][i][0] * rstd * g4[i][0], v[j][i][1] * rstd * g4[i][1]); w.y = cvtpk(v[j][i][2] * rstd * g4[i][2], v[j][i][3] * rstd * g4[i][3]);
        *(u32x2*)(xn + (size_t)m * ld + i * 256 + lane * 4) = w;
      }
      if (from_input && m >= META0) {
        float* hm = (float*)(p.ws + O_HMETA) + (size_t)(m - META0) * 1024;
#pragma unroll
        for (int i = 0; i < 4; ++i) *(f32x4*)(hm + i * 256 + lane * 4) = v[j][i];
      }
    }
  }
}

DEVI void phase_final_norm(const Params& p) {
  const int lane = otid() & 63;
  const int wgid = blockIdx.x * 8 + (otid() >> 6), nwaves = gridDim.x * 8;
  f32x4 g4[4];
#pragma unroll
  for (int i = 0; i < 4; ++i) g4[i] = *(const f32x4*)(p.norm_final + i * 256 + lane * 4);
  for (int m = wgid; m < NREAL; m += nwaves) {
    float* row = p.out + (size_t)m * 1024;
    f32x4 v[4]; float ss = 0.f;
#pragma unroll
    for (int i = 0; i < 4; ++i) { v[i] = *(const f32x4*)(row + i * 256 + lane * 4); ss += v[i][0] * v[i][0] + v[i][1] * v[i][1] + v[i][2] * v[i][2] + v[i][3] * v[i][3]; }
#pragma unroll
    for (int o = 32; o >= 1; o >>= 1) ss += __shfl_xor(ss, o);
    const float rstd = rsqrtf(ss * (1.f / 1024.f) + 1e-6f);
#pragma unroll
    for (int i = 0; i < 4; ++i) { f32x4 w = v[i] * rstd * g4[i]; *(f32x4*)(row + i * 256 + lane * 4) = w; }
  }
}

DEVI void phase_carry(const Params& p) {
  char* ws = p.ws;
  const float2* Apow = (const float2*)(ws + O_APOW);
  const float* Sloc = (const float*)(ws + O_ARENA + A_SLOC); bf16_t* carry = (bf16_t*)(ws + O_ARENA + A_CARRY);
  const int gtid = blockIdx.x * 512 + otid(), nthr = gridDim.x * 512;
  for (int idx = gtid; idx < 10 * 32 * 2 * 64; idx += nthr) {
    const int pp = idx & 63, dir = (idx >> 6) & 1, g = (idx >> 7) & 31, seq = idx >> 12;
    const float2 aT = Apow[((dir * 32 + g) * 33 + 32) * 64 + pp];
    const int len = seq < 2 ? 16384 : 2048;
    const int rb = seq < 2 ? seq * 16384 : 32768 + (seq - 2) * 2048;
    const int n = 2 + len / 32, mc0 = (META0 + 64 * seq) / 32, rc0 = rb / 32;
    float cr = 0.f, ci = 0.f;
    const int col = g * 256 + dir * 128 + pp;
#pragma unroll 1
    for (int b0 = 0; b0 < n; b0 += 8) {
      float sr[8], si[8]; int off[8];
#pragma unroll
      for (int k = 0; k < 8; ++k) {
        int ii = b0 + k; if (ii > n - 1) ii = n - 1;
        const int i = dir == 0 ? ii : n - 1 - ii;
        const int ch = i < 2 ? mc0 + i : rc0 + (i - 2);
        off[k] = ch * 8192 + col;
        sr[k] = Sloc[off[k]]; si[k] = Sloc[off[k] + 64];
      }
#pragma unroll
      for (int k = 0; k < 8; ++k) {
        if (b0 + k < n) {
          carry[off[k]] = f2bf(cr); carry[off[k] + 64] = f2bf(ci);
          const float nr = aT.x * cr - aT.y * ci + sr[k], ni = aT.x * ci + aT.y * cr + si[k];
          cr = nr; ci = ni;
        }
      }
    }
  }
}

DEVI void phase_latent_rstd(const Params& p) {
  char* ar = p.ws + O_ARENA;
  const bf16_t* cq = (const bf16_t*)(ar + A_CQ); const bf16_t* ckv = (const bf16_t*)(ar + A_CKV);
  float* rs = (float*)(p.ws + O_RSTD);
  const int tid = otid(), l32 = tid & 31;
  const int hw = blockIdx.x * 16 + (tid >> 5), nhw = gridDim.x * 16;
  for (int m = hw; m < MPAD; m += nhw) {
    float sq = 0.f, sk = 0.f;
#pragma unroll
    for (int i = 0; i < 3; ++i) { const f32x4 v = unpack4(*(const u32x2*)(cq + (size_t)m * 384 + i * 128 + l32 * 4)); sq += v[0] * v[0] + v[1] * v[1] + v[2] * v[2] + v[3] * v[3]; }
#pragma unroll
    for (int i = 0; i < 2; ++i) { const f32x4 v = unpack4(*(const u32x2*)(ckv + (size_t)m * 256 + i * 128 + l32 * 4)); sk += v[0] * v[0] + v[1] * v[1] + v[2] * v[2] + v[3] * v[3]; }
#pragma unroll
    for (int o = 16; o >= 1; o >>= 1) { sq += __shfl_xor(sq, o); sk += __shfl_xor(sk, o); }
    if (l32 == 0) { rs[m * 2] = rsqrtf(sq * (1.f / 384.f) + 1e-6f); rs[m * 2 + 1] = rsqrtf(sk * (1.f / 256.f) + 1e-6f); }
  }
}

template <int MI, class F>
DEVI void epi_tile(const f32x16 (&acc)[MI][2], char* lds, F f) {
  const int lane = otid() & 63, wid = otid() >> 6, r32 = lane & 31, hi = lane >> 5;
  float* blk = (float*)(lds + wid * 8192);
#pragma unroll
  for (int mi = 0; mi < MI; ++mi) {
#pragma unroll
    for (int ni = 0; ni < 2; ++ni)
#pragma unroll
      for (int r = 0; r < 16; ++r) blk[crow(r, hi) * 64 + ni * 32 + r32] = acc[mi][ni][r];
    asm volatile("s_waitcnt lgkmcnt(0)" ::: "memory");
    __builtin_amdgcn_wave_barrier();
#pragma unroll
    for (int q = 0; q < 8; ++q) {
      const int row = q * 4 + (lane >> 4), col = (lane & 15) * 4;
      const f32x4 v = *(const f32x4*)(blk + row * 64 + col);
      f(mi * 32 + row, col, v);
    }
    asm volatile("s_waitcnt lgkmcnt(0)" ::: "memory");
    __builtin_amdgcn_wave_barrier();
  }
}
template <int MI, class F>
DEVI void epi_tile_pair(const f32x16 (&acc)[MI][2], char* lds, F f) {
  const int lane = otid() & 63, wid = otid() >> 6, r32 = lane & 31, hi = lane >> 5;
  float* blk = (float*)(lds + wid * 8192);
#pragma unroll
  for (int mi = 0; mi < MI; ++mi) {
#pragma unroll
    for (int ni = 0; ni < 2; ++ni)
#pragma unroll
      for (int r = 0; r < 16; ++r) blk[crow(r, hi) * 64 + ni * 32 + r32] = acc[mi][ni][r];
    asm volatile("s_waitcnt lgkmcnt(0)" ::: "memory");
    __builtin_amdgcn_wave_barrier();
#pragma unroll
    for (int q = 0; q < 4; ++q) {
      const int row = q * 8 + (lane >> 3), col = (lane & 7) * 4;
      const f32x4 v1 = *(const f32x4*)(blk + row * 64 + col);
      const f32x4 v2 = *(const f32x4*)(blk + row * 64 + 32 + col);
      f(mi * 32 + row, col, v1, v2);
    }
    asm volatile("s_waitcnt lgkmcnt(0)" ::: "memory");
    __builtin_amdgcn_wave_barrier();
  }
}
DEVI u32x2 pack4(f32x4 v) { u32x2 w; w.x = cvtpk(v[0], v[1]); w.y = cvtpk(v[2], v[3]); return w; }

template <int MI, class PT, class P, class F>
DEVI void epi_tile_pf(const f32x16 (&acc)[MI][2], char* lds, P pre, F f) {
  const int lane = otid() & 63, wid = otid() >> 6, r32 = lane & 31, hi = lane >> 5;
  float* blk = (float*)(lds + wid * 8192);
#pragma unroll
  for (int mi = 0; mi < MI; ++mi) {
    PT pv[8];
#pragma unroll
    for (int q = 0; q < 8; ++q) pv[q] = pre(mi * 32 + q * 4 + (lane >> 4), (lane & 15) * 4);
#pragma unroll
    for (int ni = 0; ni < 2; ++ni)
#pragma unroll
      for (int r = 0; r < 16; ++r) blk[crow(r, hi) * 64 + ni * 32 + r32] = acc[mi][ni][r];
    asm volatile("s_waitcnt lgkmcnt(0)" ::: "memory");
    __builtin_amdgcn_wave_barrier();
#pragma unroll
    for (int q = 0; q < 8; ++q) {
      const int row = q * 4 + (lane >> 4), col = (lane & 15) * 4;
      const f32x4 v = *(const f32x4*)(blk + row * 64 + col);
      f(mi * 32 + row, col, v, pv[q]);
    }
    asm volatile("s_waitcnt lgkmcnt(0)" ::: "memory");
    __builtin_amdgcn_wave_barrier();
  }
}
DEVI void phase_proj(const Params& p, char* lds) {
  char* ar = p.ws + O_ARENA;
  const bf16_t* xn = (const bf16_t*)(ar + A_XN1); const bf16_t* W = (const bf16_t*)(p.ws + O_WIN);
  bf16_t* u = (bf16_t*)(ar + A_U); bf16_t* cq = (bf16_t*)(ar + A_CQ); bf16_t* ckv = (bf16_t*)(ar + A_CKV); bf16_t* kr = (bf16_t*)(ar + A_KR);
  const float2* rope = (const float2*)(p.ws + O_ROPE);
  const int wid = otid() >> 6, wm = wid >> 2, wn = wid & 3;
  GStage<2> st;
  int nt, mt; bool have = unit_xcd(0, 390, 5, mt, nt);
  if (have) gemm_prefetch<2>(st, xn + (size_t)mt * 128 * 1024, 1024, 128, 30, 0, W + (size_t)nt * 256 * 1024, 1024, 1024);
  for (int ui = 0; have; ++ui) {
    f32x16 acc[2][2]; zero_acc<2>(acc);
    gemm_main<2, 1, 4>(acc, st, xn + (size_t)mt * 128 * 1024, 1024, 128, 30, 0, W + (size_t)nt * 256 * 1024, 1024, 1024, lds);
    int nt2, mt2; const bool hn = unit_xcd(ui + 1, 390, 5, mt2, nt2);
    if (hn) gemm_prefetch<2>(st, xn + (size_t)mt2 * 128 * 1024, 1024, 128, 30, 0, W + (size_t)nt2 * 256 * 1024, 1024, 1024);
    const int nb = nt * 256 + wn * 64, m0 = mt * 128 + wm * 64;
    if (nb < 1152) {
      bf16_t* dst; int ld, c0;
      if (nb < 512) { dst = u; ld = 512; c0 = nb; } else if (nb < 896) { dst = cq; ld = 384; c0 = nb - 512; } else { dst = ckv; ld = 256; c0 = nb - 896; }
      dst += (size_t)m0 * ld + c0;
      epi_tile<2>(acc, lds, [&](int row, int col, f32x4 v) { *(u32x2*)(dst + row * ld + col) = pack4(v); });
    } else if (nb == 1152) {
      bf16_t* dst = kr + (size_t)m0 * 64;
      epi_tile_pair<2>(acc, lds, [&](int row, int col, f32x4 x1, f32x4 x2) {
        const float2* cs = rope + pos_of_row(m0 + row) * 32 + col;
        f32x4 o1, o2;
#pragma unroll
        for (int e = 0; e < 4; ++e) { const float2 c = cs[e]; o1[e] = x1[e] * c.x - x2[e] * c.y; o2[e] = x1[e] * c.y + x2[e] * c.x; }
        *(u32x2*)(dst + row * 64 + col) = pack4(o1); *(u32x2*)(dst + row * 64 + 32 + col) = pack4(o2);
      });
    }
    mt = mt2; nt = nt2; have = hn;
  }
}

DEVI void phase_s5a1(const Params& p, char* lds) {
  char* ar = p.ws + O_ARENA;
  const bf16_t* u = (const bf16_t*)(ar + A_U); const bf16_t* W1T = (const bf16_t*)(p.ws + O_W1T); float* Sloc = (float*)(ar + A_SLOC);
  const int wid = otid() >> 6, wm = wid >> 2, wn = wid & 3;
  for (int un = blockIdx.x; un < 13 * 32; un += gridDim.x) {
    const int g = un & 31, rt = un >> 5;
    f32x16 acc[2][2]; zero_acc<2>(acc);
    gemm_acc<2>(acc, u + (size_t)rt * 128 * 16384 + g * 16, 16384, NCHUNK - rt * 128, 4, 512, W1T + (size_t)g * 256 * 512, 512, 512, lds);
    float* dst = Sloc + ((size_t)(rt * 128 + wm * 64) * 32 + g) * 256 + wn * 64;
    epi_tile<2>(acc, lds, [&](int row, int col, f32x4 v) { *(f32x4*)(dst + row * 8192 + col) = v; });
  }
}

DEVI void phase_s5a3(const Params& p, char* lds) {
  char* ar = p.ws + O_ARENA;
  const bf16_t* u = (const bf16_t*)(ar + A_U); const bf16_t* carry = (const bf16_t*)(ar + A_CARRY);
  const bf16_t* W3T = (const bf16_t*)(p.ws + O_W3T); bf16_t* z1 = (bf16_t*)(ar + A_Z1);
  const int wid = otid() >> 6, wm = wid >> 2, wn = wid & 3;
  for (int un = blockIdx.x; un < 13 * 32 * 2; un += gridDim.x) {
    const int nt = un & 1, g = (un >> 1) & 31, rt = un >> 6;
    f32x16 acc[2][2]; zero_acc<2>(acc);
    const bf16_t* Bt = W3T + (size_t)(g * 512 + nt * 256) * 768;
    gemm_acc<2>(acc, u + (size_t)rt * 128 * 16384 + g * 16, 16384, NCHUNK - rt * 128, 4, 512, Bt, 768, 512, lds);
    gemm_acc<2>(acc, carry + (size_t)rt * 128 * 8192 + g * 256, 8192, 128, 30, 0, Bt + 512, 768, 256, lds);
    const int c0 = rt * 128 + wm * 64, nb = nt * 256 + wn * 64;
    bf16_t* dst = z1 + (size_t)c0 * 16384 + g * 16;
    epi_tile<2>(acc, lds, [&](int row, int col, f32x4 v) {
      if (c0 + row < NCHUNK) {
        const int n = nb + col, j = n >> 4, h = n & 15;
        f32x4 o;
#pragma unroll
        for (int e = 0; e < 4; ++e) { const float y = v[e]; const float t = 1.5957691216057308f * (y + 0.044715f * y * y * y); o[e] = y * sigmoidf_(t); }
        *(u32x2*)(dst + row * 16384 + j * 512 + h) = pack4(o);
      }
    });
  }
}

DEVI void phase_glu(const Params& p, int L, char* lds) {
  char* ar = p.ws + O_ARENA;
  const bf16_t* z1 = (const bf16_t*)(ar + A_Z1); const bf16_t* W = (const bf16_t*)(p.ws + O_WGLU); bf16_t* z2 = (bf16_t*)(ar + A_Z2);
  const float* bg = p.b_glu + L * 512;
  const int wid = otid() >> 6, wm = wid >> 2, wn = wid & 3;
  for (int ui = 0;; ++ui) {
    int nt, mt; if (!unit_xcd(ui, 390, 2, mt, nt)) break;
    f32x16 acc[2][2]; zero_acc<2>(acc);
    gemm_acc<2>(acc, z1 + (size_t)mt * 128 * 512, 512, 128, 30, 0, W + (size_t)nt * 256 * 512, 512, 512, lds);
    const int nb = nt * 256 + wn * 64, m0 = mt * 128 + wm * 64;
    const bf16_t* src = z1 + (size_t)m0 * 512 + nb; bf16_t* dst = z2 + (size_t)m0 * 512 + nb; const float* bb = bg + nb;
    epi_tile_pf<2, u32x2>(acc, lds, [&](int row, int col) { return *(const u32x2*)(src + row * 512 + col); },
                          [&](int row, int col, f32x4 v, u32x2 zz) {
      const f32x4 z = unpack4(zz);
      const f32x4 b = *(const f32x4*)(bb + col);
      f32x4 o;
#pragma unroll
      for (int e = 0; e < 4; ++e) o[e] = z[e] * sigmoidf_(v[e] + b[e]);
      *(u32x2*)(dst + row * 512 + col) = pack4(o);
    });
  }
}

DEVI void phase_qkv(const Params& p, int grp, char* lds) {
  char* ar = p.ws + O_ARENA;
  const bf16_t* cq = (const bf16_t*)(ar + A_CQ); const bf16_t* ckv = (const bf16_t*)(ar + A_CKV);
  bf16_t* qg = (bf16_t*)(ar + A_QG); bf16_t* kvg = (bf16_t*)(ar + A_KVG);
  const bf16_t* Wq = (const bf16_t*)(p.ws + O_WUQ); const bf16_t* Wkv = (const bf16_t*)(p.ws + O_WUKV);
  const float2* rope = (const float2*)(p.ws + O_ROPE);
  float* rstd_l = (float*)(lds + 131072);
  const int tid = otid(), wid = tid >> 6, wm = wid >> 2, wn = wid & 3;
  const int greal0 = grp * 16384, seq0 = grp < 2 ? grp : 2;
  for (int un = blockIdx.x; un < 132 * 14; un += gridDim.x) {
    const bool iskv = un < 132 * 8;
    const int v = iskv ? un : un - 132 * 8;
    const int nt = iskv ? (v & 7) : (v % 6), lt = iskv ? (v >> 3) : (v / 6);
    const int gb = lt < 128 ? greal0 + lt * 128 : META0 + 64 * seq0 + (lt - 128) * 128;
    const int arows = MPAD - gb;
    const int KL = iskv ? 256 : 384;
    const bf16_t* A = (iskv ? ckv : cq) + (size_t)gb * KL;
    if (tid < 128) { int gr = gb + tid; if (gr > MPAD - 1) gr = MPAD - 1; rstd_l[tid] = ((const float*)(p.ws + O_RSTD))[gr * 2 + (iskv ? 1 : 0)]; }
    f32x16 acc[2][2]; zero_acc<2>(acc);
    gemm_acc<2>(acc, A, KL, arows, 30, 0, (iskv ? Wkv : Wq) + (size_t)nt * 256 * KL, KL, KL, lds);
    const int nb = nt * 256 + wn * 64, ml0 = wm * 64;
    const bool ropeslab = !iskv && ((nb >> 6) % 3) == 2;
    if (!ropeslab) {
      const int ld = iskv ? 2048 : 1536;
      bf16_t* dst = (iskv ? kvg : qg) + (size_t)(lt * 128 + ml0) * ld + nb;
      epi_tile<2>(acc, lds, [&](int row, int col, f32x4 vv) {
        const float rs = rstd_l[ml0 + row];
        *(u32x2*)(dst + row * ld + col) = pack4(vv * rs);
      });
    } else {
      bf16_t* dst = qg + (size_t)(lt * 128 + ml0) * 1536 + nb;
      epi_tile_pair<2>(acc, lds, [&](int row, int col, f32x4 x1, f32x4 x2) {
        int gm = gb + ml0 + row; if (gm >= MPAD) gm = MPAD - 1;
        const float2* cs = rope + pos_of_row(gm) * 32 + col;
        const float rs = rstd_l[ml0 + row];
        f32x4 o1, o2;
#pragma unroll
        for (int e = 0; e < 4; ++e) { const float2 c = cs[e]; const float a = x1[e] * rs, b = x2[e] * rs; o1[e] = a * c.x - b * c.y; o2[e] = a * c.y + b * c.x; }
        *(u32x2*)(dst + row * 1536 + col) = pack4(o1); *(u32x2*)(dst + row * 1536 + 32 + col) = pack4(o2);
      });
    }
    __syncthreads();
  }
}

DEVI void phase_merge(const Params& p, char* lds) {
  constexpr int MIV = 2;
  char* ar = p.ws + O_ARENA;
  const bf16_t* xn = (const bf16_t*)(ar + A_XN2); const bf16_t* z2 = (const bf16_t*)(ar + A_Z2); const bf16_t* o = (const bf16_t*)(ar + A_O);
  bf16_t* mg = (bf16_t*)(ar + A_MERGED);
  const bf16_t* Wg = (const bf16_t*)(p.ws + O_WG); const bf16_t* Wssm = (const bf16_t*)(p.ws + O_WSSM); const bf16_t* Wattn = (const bf16_t*)(p.ws + O_WATTN);
  const int wid = otid() >> 6, wm = wid >> 2, wn = wid & 3;
  GStage<2> st;
  int nt, mt; bool have = unit_xcd(0, 390, 4, mt, nt);
  if (have) gemm_prefetch<2>(st, xn + (size_t)mt * 128 * 1024, 1024, 128, 30, 0, Wg + (size_t)(nt * 256) * 1024, 1024, 1024);
  for (int ui = 0; have; ++ui) {
    const int nb = nt * 256 + wn * 64, m0 = mt * 128 + wm * 64;
    bf16_t* dst = mg + (size_t)m0 * 1024 + nb;
    unsigned spk[2][2][8];
    f32x16 acc[2][2];
    zero_acc<2>(acc);
    gemm_main<2>(acc, st, xn + (size_t)mt * 128 * 1024, 1024, 128, 30, 0, Wg + (size_t)(nt * 256) * 1024, 1024, 1024, lds);
    gemm_prefetch<2>(st, z2 + (size_t)mt * 128 * 512, 512, 128, 30, 0, Wssm + (size_t)(nt * 256) * 512, 512, 512);
    FOR_MN(mi, ni) {
#pragma unroll
      for (int q = 0; q < 8; ++q) spk[mi][ni][q] = cvtpk(sigmoidf_(acc[mi][ni][2 * q]), sigmoidf_(acc[mi][ni][2 * q + 1]));
    }
    zero_acc<2>(acc);
    gemm_main<2>(acc, st, z2 + (size_t)mt * 128 * 512, 512, 128, 30, 0, Wssm + (size_t)(nt * 256) * 512, 512, 512, lds);
    gemm_prefetch<2>(st, xn + (size_t)mt * 128 * 1024, 1024, 128, 30, 0, Wg + (size_t)(1024 + nt * 256) * 1024, 1024, 1024);
    FOR_MN(mi, ni) {
#pragma unroll
      for (int q = 0; q < 8; ++q) {
        const unsigned w = spk[mi][ni][q];
        acc[mi][ni][2 * q] *= __uint_as_float(w << 16); acc[mi][ni][2 * q + 1] *= __uint_as_float(w & 0xffff0000u);
      }
    }
    epi_tile<2>(acc, lds, [&](int row, int col, f32x4 v) { *(u32x2*)(dst + row * 1024 + col) = pack4(v); });
    zero_acc<2>(acc);
    gemm_main<2>(acc, st, xn + (size_t)mt * 128 * 1024, 1024, 128, 30, 0, Wg + (size_t)(1024 + nt * 256) * 1024, 1024, 1024, lds);
    gemm_prefetch<2>(st, o + (size_t)mt * 128 * 1024, 1024, 128, 30, 0, Wattn + (size_t)(nt * 256) * 1024, 1024, 1024);
    FOR_MN(mi, ni) {
#pragma unroll
      for (int q = 0; q < 8; ++q) spk[mi][ni][q] = cvtpk(sigmoidf_(acc[mi][ni][2 * q]), sigmoidf_(acc[mi][ni][2 * q + 1]));
    }
    zero_acc<2>(acc);
    gemm_main<2>(acc, st, o + (size_t)mt * 128 * 1024, 1024, 128, 30, 0, Wattn + (size_t)(nt * 256) * 1024, 1024, 1024, lds);
    int nt2, mt2; const bool hn = unit_xcd(ui + 1, 390, 4, mt2, nt2);
    if (hn) gemm_prefetch<2>(st, xn + (size_t)mt2 * 128 * 1024, 1024, 128, 30, 0, Wg + (size_t)(nt2 * 256) * 1024, 1024, 1024);
    FOR_MN(mi, ni) {
#pragma unroll
      for (int q = 0; q < 8; ++q) {
        const unsigned w = spk[mi][ni][q];
        acc[mi][ni][2 * q] *= __uint_as_float(w << 16); acc[mi][ni][2 * q + 1] *= __uint_as_float(w & 0xffff0000u);
      }
    }
    epi_tile_pf<2, u32x2>(acc, lds, [&](int row, int col) { return *(const u32x2*)(dst + row * 1024 + col); },
                          [&](int row, int col, f32x4 v, u32x2 mm) { *(u32x2*)(dst + row * 1024 + col) = pack4(unpack4(mm) + v); });
    mt = mt2; nt = nt2; have = hn;
  }
}

DEVI void phase_resid_gemm(const Params& p, const bf16_t* __restrict__ A, int K, const bf16_t* __restrict__ Bt, bool layer0_resid, char* lds) {
  const int wid = otid() >> 6, wm = wid >> 2, wn = wid & 3;
  GStage<2> st;
  int nt, mt; bool have = unit_xcd(0, 390, 4, mt, nt);
  if (have) gemm_prefetch<2>(st, A + (size_t)mt * 128 * K, K, 128, 30, 0, Bt + (size_t)(nt * 256) * K, K, K);
  for (int ui = 0; have; ++ui) {
    f32x16 acc[2][2]; zero_acc<2>(acc);
    gemm_main<2, 1, 4>(acc, st, A + (size_t)mt * 128 * K, K, 128, 30, 0, Bt + (size_t)(nt * 256) * K, K, K, lds);
    int nt2, mt2; const bool hn = unit_xcd(ui + 1, 390, 4, mt2, nt2);
    if (hn) gemm_prefetch<2>(st, A + (size_t)mt2 * 128 * K, K, 128, 30, 0, Bt + (size_t)(nt2 * 256) * K, K, K);
    float* hb = mt < 384 ? p.out + (size_t)mt * 128 * 1024 : (float*)(p.ws + O_HMETA) + (size_t)(mt - 384) * 128 * 1024;
    const float* rb = hb;
    if (layer0_resid && mt < 384) rb = mt < 256 ? p.x_prompt + (size_t)mt * 128 * 1024 : p.x_sample + (size_t)(mt - 256) * 128 * 1024;
    const int nb = nt * 256 + wn * 64, ml0 = wm * 64;
    hb += ml0 * 1024 + nb; rb += ml0 * 1024 + nb;
    const int lr0 = mt >= 384 ? (mt - 384) * 128 + ml0 : -1;
    epi_tile_pf<2, f32x4>(acc, lds, [&](int row, int col) { return *(const f32x4*)(rb + row * 1024 + col); },
                          [&](int row, int col, f32x4 v, f32x4 res) {
      f32x4 r = res + v;
      if (lr0 >= 0 && is_pad_lr(lr0 + row)) r = (f32x4){0.f, 0.f, 0.f, 0.f};
      *(f32x4*)(hb + row * 1024 + col) = r;
    });
    mt = mt2; nt = nt2; have = hn;
  }
}

DEVI void phase_ffn_up(const Params& p, char* lds) {
  char* ar = p.ws + O_ARENA;
  const bf16_t* xn = (const bf16_t*)(ar + A_XN3); const bf16_t* W = (const bf16_t*)(p.ws + O_WGU); bf16_t* hid = (bf16_t*)(ar + A_HID);
  const int wid = otid() >> 6, wm = wid >> 2, wn = wid & 3;
  for (int ui = 0;; ++ui) {
    int nt, mt; if (!unit_xcd_cb(ui, 195, 22, 4, mt, nt)) break;
    f32x16 acc[4][2]; zero_acc<4>(acc);
    gemm_acc<4, 1>(acc, xn + (size_t)mt * 256 * LDX, LDX, 256, 30, 0, W + (size_t)(nt * 256) * LDX, LDX, 1024, lds);
    bf16_t* dst = hid + (size_t)(mt * 256 + wm * 128) * 2816 + (nt * 4 + wn) * 32;
    epi_tile_pair<4>(acc, lds, [&](int row, int col, f32x4 g, f32x4 uu) {
      f32x4 o;
#pragma unroll
      for (int e = 0; e < 4; ++e) o[e] = g[e] * sigmoidf_(g[e]) * uu[e];
      *(u32x2*)(dst + row * 2816 + col) = pack4(o);
    });
  }
}

constexpr float ATT_SCALE = 0.07216878364870322f;
constexpr float ATT_THR = 8.f;
#define KSWZ(row, colB) ((row) * 256 + ((colB) ^ (((row) & 15) << 4)))

DEVI void partialSM(f32x16& p0, f32x16& p1, float& m_reg, float& mn, float& alpha) {
  constexpr float C = ATT_SCALE * 1.4426950408889634f;
  float pmax = p0[0];
#pragma unroll
  for (int r = 1; r < 16; ++r) pmax = fmaxf(pmax, p0[r]);
#pragma unroll
  for (int r = 0; r < 16; ++r) pmax = fmaxf(pmax, p1[r]);
  { auto rr = __builtin_amdgcn_permlane32_swap(__float_as_uint(pmax), __float_as_uint(pmax), false, false);
    pmax = fmaxf(__uint_as_float(rr[0]), __uint_as_float(rr[1])); }
  if (__builtin_expect(__all(pmax - m_reg <= ATT_THR / ATT_SCALE), 1)) { mn = m_reg; alpha = 1.f; }
  else { mn = fmaxf(m_reg, pmax); alpha = __builtin_amdgcn_exp2f((m_reg - mn) * C); m_reg = mn; }
  const float mnC = -mn * C;
#pragma unroll
  for (int r = 0; r < 16; ++r) p0[r] = fmaf(p0[r], C, mnC);
#pragma unroll
  for (int r = 0; r < 16; ++r) p1[r] = fmaf(p1[r], C, mnC);
#pragma unroll
  for (int r = 0; r < 16; ++r) p0[r] = __builtin_amdgcn_exp2f(p0[r]);
}
DEVI void finishSM(f32x16& p0, f32x16& p1, float alpha, float& l_reg, bf16x8& pa0, bf16x8& pa1, bf16x8& pa2, bf16x8& pa3) {
#pragma unroll
  for (int r = 0; r < 16; ++r) p1[r] = __builtin_amdgcn_exp2f(p1[r]);
  float ps = 0;
#pragma unroll
  for (int r = 0; r < 16; ++r) ps += p0[r];
#pragma unroll
  for (int r = 0; r < 16; ++r) ps += p1[r];
  { auto rr = __builtin_amdgcn_permlane32_swap(__float_as_uint(ps), __float_as_uint(ps), false, false);
    ps = __uint_as_float(rr[0]) + __uint_as_float(rr[1]); }
  l_reg = l_reg * alpha + ps;
#define PK4(P, BASE, OUT) do { unsigned a0 = cvtpk(P[BASE + 0], P[BASE + 1]), a1 = cvtpk(P[BASE + 2], P[BASE + 3]);   \
    unsigned b0 = cvtpk(P[BASE + 4], P[BASE + 5]), b1 = cvtpk(P[BASE + 6], P[BASE + 7]);                              \
    auto r0 = __builtin_amdgcn_permlane32_swap(a0, b0, false, false); auto r1 = __builtin_amdgcn_permlane32_swap(a1, b1, false, false); \
    u32x4 w = {r0[0], r1[0], r0[1], r1[1]}; OUT = *reinterpret_cast<bf16x8*>(&w); } while (0)
  PK4(p0, 0, pa0); PK4(p0, 8, pa1); PK4(p1, 0, pa2); PK4(p1, 8, pa3);
#undef PK4
}
DEVI void qkt(f32x16& p0, f32x16& p1, const char* Kn, const char* Kr, const bf16x8* qr, const char* qrl, int r32, int hi) {
#pragma unroll
  for (int r = 0; r < 16; ++r) { p0[r] = 0.f; p1[r] = 0.f; }
#pragma unroll
  for (int d0 = 0; d0 < 8; ++d0) { const int cb = (d0 * 16 + hi * 8) * 2;
    const bf16x8 b0 = *reinterpret_cast<const bf16x8*>(Kn + KSWZ(r32, cb));
    const bf16x8 b1 = *reinterpret_cast<const bf16x8*>(Kn + KSWZ(32 + r32, cb));
    bf16x8 qv;
    if (d0 < 4) qv = qr[d0]; else qv = *reinterpret_cast<const bf16x8*>(qrl + (d0 - 4) * 1024);
    p0 = __builtin_amdgcn_mfma_f32_32x32x16_bf16(b0, qv, p0, 0, 0, 0);
    p1 = __builtin_amdgcn_mfma_f32_32x32x16_bf16(b1, qv, p1, 0, 0, 0); }
  const int swz = (r32 >> 1) & 7;
#pragma unroll
  for (int d0 = 0; d0 < 4; ++d0) { const int so = ((d0 * 2 + hi) ^ swz) << 4;
    const bf16x8 b0 = *reinterpret_cast<const bf16x8*>(Kr + r32 * 128 + so);
    const bf16x8 b1 = *reinterpret_cast<const bf16x8*>(Kr + (32 + r32) * 128 + so);
    const bf16x8 qv = *reinterpret_cast<const bf16x8*>(qrl + (4 + d0) * 1024);
    p0 = __builtin_amdgcn_mfma_f32_32x32x16_bf16(b0, qv, p0, 0, 0, 0);
    p1 = __builtin_amdgcn_mfma_f32_32x32x16_bf16(b1, qv, p1, 0, 0, 0); }
}
DEVI int v_st(int k, int c) { const int kk = (k & ~0xC) | ((k & 4) << 1) | ((k & 8) >> 1); return ((kk >> 3) * 4 + (c >> 5)) * 512 + ((kk & 7) * 32 + (c & 31)) * 2; }
DEVI int v_rd_base(int lane) { return ((lane & 3) << 3) | (((lane >> 2) & 3) << 6) | (((lane >> 4) & 1) << 5) | (((lane >> 5) & 1) << 8); }
constexpr int v_rd_off(int d0, int ks, int half) { return d0 * 512 + ks * 4096 + half * 2048; }
template <int OFF> DEVI s16x4 tr_read(int vb) {
  s16x4 r; asm volatile("ds_read_b64_tr_b16 %0, %1 offset:%2" : "=&v"(r) : "v"(vb), "i"(OFF) : "memory"); return r;
}
template <int D0> DEVI void pv_one(f32x16& od, int vb, bf16x8 pa0, bf16x8 pa1, bf16x8 pa2, bf16x8 pa3) {
  const s16x4 l0 = tr_read<v_rd_off(D0, 0, 0)>(vb), h0 = tr_read<v_rd_off(D0, 0, 1)>(vb), l1 = tr_read<v_rd_off(D0, 1, 0)>(vb), h1 = tr_read<v_rd_off(D0, 1, 1)>(vb);
  const s16x4 l2 = tr_read<v_rd_off(D0, 2, 0)>(vb), h2 = tr_read<v_rd_off(D0, 2, 1)>(vb), l3 = tr_read<v_rd_off(D0, 3, 0)>(vb), h3 = tr_read<v_rd_off(D0, 3, 1)>(vb);
  asm volatile("s_waitcnt lgkmcnt(0)" ::: "memory"); SBAR();
#define PK(L, H) (bf16x8){L[0], L[1], L[2], L[3], H[0], H[1], H[2], H[3]}
  od = __builtin_amdgcn_mfma_f32_32x32x16_bf16(pa0, PK(l0, h0), od, 0, 0, 0);
  od = __builtin_amdgcn_mfma_f32_32x32x16_bf16(pa1, PK(l1, h1), od, 0, 0, 0);
  od = __builtin_amdgcn_mfma_f32_32x32x16_bf16(pa2, PK(l2, h2), od, 0, 0, 0);
  od = __builtin_amdgcn_mfma_f32_32x32x16_bf16(pa3, PK(l3, h3), od, 0, 0, 0);
#undef PK
}
DEVI void pv_d0(f32x16* o, int vb, bf16x8 pa0, bf16x8 pa1, bf16x8 pa2, bf16x8 pa3) {
  pv_one<0>(o[0], vb, pa0, pa1, pa2, pa3); pv_one<1>(o[1], vb, pa0, pa1, pa2, pa3); pv_one<2>(o[2], vb, pa0, pa1, pa2, pa3); pv_one<3>(o[3], vb, pa0, pa1, pa2, pa3);
}

DEVI void attn_unit(const bf16_t* __restrict__ Qg, const bf16_t* __restrict__ KVg, const bf16_t* __restrict__ KR, bf16_t* __restrict__ O,
                    int qrow0, int vlo, int vhi, int orow0, int lmeta, int lreal, int gmeta, int greal, int head, int t0, int NT, float* __restrict__ part, char* lds) {
  const int tid = otid(), wid = tid >> 6, lane = tid & 63, r32 = lane & 31, hi = lane >> 5;
  char* V_lds = lds; char* Kn_lds = lds + 32768; char* Kr_lds = lds + 65536;
  float* wsf = (float*)(lds + 81920) + wid * 64; float* li_l = wsf; float* al_l = wsf + 32;
  float m_reg = -1e30f, l_reg = 0; f32x16 o[4]; bf16x8 qr[4];
  char* qrl = lds + 83968 + wid * 8192 + lane * 16;
#pragma unroll
  for (int d = 0; d < 4; ++d)
#pragma unroll
    for (int r = 0; r < 16; ++r) o[d][r] = 0.f;
  { int qrow = qrow0 + wid * 32 + r32; if (qrow > QG_ROWS - 1) qrow = QG_ROWS - 1;
    const bf16_t* Qw = Qg + (size_t)qrow * 1536 + head * 192 + hi * 8;
#pragma unroll
    for (int d0 = 0; d0 < 4; ++d0) qr[d0] = *reinterpret_cast<const bf16x8*>(Qw + d0 * 16);
#pragma unroll
    for (int d0 = 0; d0 < 8; ++d0) *reinterpret_cast<bf16x8*>(qrl + d0 * 1024) = *reinterpret_cast<const bf16x8*>(Qw + (4 + d0) * 16); }
  const int sr = tid >> 4, sc = (tid & 15) * 8, vst0 = v_st(sr, sc), vst1 = v_st(32 + sr, sc);
  const int krow = tid >> 3, kslot = tid & 7, krofs = krow * 128 + ((kslot ^ ((krow >> 1) & 7)) << 4);
  const int vb0 = (int)(uintptr_t)V_lds + v_rd_base(lane);
  bf16x8 vs0, vs1, ks0, ks1, rs0;
#define SLOAD(j) do { const int jj = t0 + (j); const int lr_ = jj == 0 ? lmeta : lreal + (jj - 1) * 64; const int gr_ = jj == 0 ? gmeta : greal + (jj - 1) * 64; \
    const bf16_t* kvp = KVg + (size_t)(lr_ + sr) * 2048 + head * 256 + sc;                                   \
    ks0 = *reinterpret_cast<const bf16x8*>(kvp); vs0 = *reinterpret_cast<const bf16x8*>(kvp + 128);           \
    ks1 = *reinterpret_cast<const bf16x8*>(kvp + 32 * 2048); vs1 = *reinterpret_cast<const bf16x8*>(kvp + 32 * 2048 + 128); \
    rs0 = *reinterpret_cast<const bf16x8*>(KR + (size_t)(gr_ + krow) * 64 + kslot * 8); } while (0)
#define SWRITE(b) do { *(bf16x8*)(V_lds + (b) * 16384 + vst0) = vs0; *(bf16x8*)(V_lds + (b) * 16384 + vst1) = vs1; const int kc = sc * 2; \
    *(bf16x8*)(Kn_lds + (b) * 16384 + KSWZ(sr, kc)) = ks0; *(bf16x8*)(Kn_lds + (b) * 16384 + KSWZ(32 + sr, kc)) = ks1;    \
    *(bf16x8*)(Kr_lds + (b) * 8192 + krofs) = rs0; } while (0)
#define SWAIT() asm volatile("s_waitcnt vmcnt(0)" ::: "memory")
#define RESC(a) do { if (__any((a) < 1.f)) { if (hi == 0) al_l[r32] = (a); asm volatile("s_waitcnt lgkmcnt(0)" ::: "memory"); \
    _Pragma("unroll") for (int d = 0; d < 4; ++d) _Pragma("unroll") for (int r = 0; r < 16; ++r) o[d][r] *= al_l[crow(r, hi)]; } } while (0)
  f32x16 pA0, pA1, pB0, pB1; float mnA, mnB, alA, alB; bf16x8 pa0, pa1, pa2, pa3;
  SLOAD(0); SWAIT(); SWRITE(0); __syncthreads();
  qkt(pA0, pA1, Kn_lds, Kr_lds, qr, qrl, r32, hi);
  if (t0 == 0) {
#pragma unroll
    for (int r = 0; r < 16; ++r) pA0[r] = -1e30f;
#pragma unroll
    for (int r = 0; r < 8; ++r) pA1[r] = -1e30f;
  }
  partialSM(pA0, pA1, m_reg, mnA, alA);
  if (NT > 1) { SLOAD(1); SWAIT(); SWRITE(1); }
  __syncthreads();
  for (int j = 1; j + 1 < NT; j += 2) {
    SBAR(); qkt(pB0, pB1, Kn_lds + 16384, Kr_lds + 8192, qr, qrl, r32, hi);
    finishSM(pA0, pA1, alA, l_reg, pa0, pa1, pa2, pa3); SBAR();
    SLOAD(j + 1); SBAR();
    pv_d0(o, vb0, pa0, pa1, pa2, pa3); partialSM(pB0, pB1, m_reg, mnB, alB);
    __syncthreads(); SWAIT(); SWRITE(0);
    RESC(alB); __syncthreads();
    SBAR(); qkt(pA0, pA1, Kn_lds, Kr_lds, qr, qrl, r32, hi);
    finishSM(pB0, pB1, alB, l_reg, pa0, pa1, pa2, pa3); SBAR();
    if (j + 2 < NT) SLOAD(j + 2); SBAR();
    pv_d0(o, vb0 + 16384, pa0, pa1, pa2, pa3); partialSM(pA0, pA1, m_reg, mnA, alA);
    __syncthreads(); SWAIT(); SWRITE(1);
    RESC(alA); __syncthreads();
  }
  if ((NT & 1) == 0) {
    SBAR(); qkt(pB0, pB1, Kn_lds + 16384, Kr_lds + 8192, qr, qrl, r32, hi);
    finishSM(pA0, pA1, alA, l_reg, pa0, pa1, pa2, pa3); SBAR();
    pv_d0(o, vb0, pa0, pa1, pa2, pa3); partialSM(pB0, pB1, m_reg, mnB, alB);
    __syncthreads(); RESC(alB);
    finishSM(pB0, pB1, alB, l_reg, pa0, pa1, pa2, pa3); SBAR();
    pv_d0(o, vb0 + 16384, pa0, pa1, pa2, pa3);
  } else {
    finishSM(pA0, pA1, alA, l_reg, pa0, pa1, pa2, pa3); SBAR();
    pv_d0(o, vb0, pa0, pa1, pa2, pa3);
  }
  if (part) {
    if (wid == 1) {
      if (hi == 0 && r32 >= 16) { part[2048 + r32 - 16] = m_reg; part[2064 + r32 - 16] = l_reg; }
#pragma unroll
      for (int r = 8; r < 16; ++r) {
        float* pw = part + (crow(r, hi) - 16) * 128 + r32;
#pragma unroll
        for (int d0 = 0; d0 < 4; ++d0) pw[d0 * 32] = o[d0][r];
      }
    }
  } else {
  if (hi == 0) li_l[r32] = l_reg; asm volatile("s_waitcnt lgkmcnt(0)" ::: "memory");
  float rli[16];
#pragma unroll
  for (int r = 0; r < 16; ++r) rli[r] = __builtin_amdgcn_rcpf(li_l[crow(r, hi)]);
#pragma unroll
  for (int r = 0; r < 16; ++r) {
    const int rb = wid * 32 + crow(r, hi);
    if (rb >= vlo && rb < vhi) {
      bf16_t* Ow = O + (size_t)(orow0 + rb) * 1024 + head * 128 + r32;
#pragma unroll
      for (int d0 = 0; d0 < 4; ++d0) Ow[d0 * 32] = f2bf(o[d0][r] * rli[r]);
    }
  }
  }
#undef SLOAD
#undef SWRITE
#undef SWAIT
#undef RESC
}

constexpr size_t A_PART = 344752128;
constexpr int PART_STRIDE = 16 * 128 + 32;
DEVI void phase_attn(const Params& p, int grp, char* lds) {
  char* ar = p.ws + O_ARENA;
  const bf16_t* qg = (const bf16_t*)(ar + A_QG); const bf16_t* kvg = (const bf16_t*)(ar + A_KVG); const bf16_t* kr = (const bf16_t*)(ar + A_KR);
  bf16_t* o = (bf16_t*)(ar + A_O); float* part = (float*)(ar + A_PART);
  const int nseq = grp < 2 ? 1 : 8, S = grp < 2 ? 16384 : 2048, nqb = S / 256;
  const int NS = grp < 2 ? 32 : 4;
  const int NUR = nseq * 8 * nqb, NU = NUR + nseq * 8 * NS, NT = 1 + S / 64;
  for (int un = blockIdx.x; un < NU; un += gridDim.x) {
    __syncthreads();
    if (un < NUR) {
      const int head = un & 7, t = un >> 3, sl = t / nqb, qb = t % nqb;
      const int seq = grp < 2 ? grp : 2 + sl;
      const int lreal = sl * S, lmeta = 16384 + 64 * sl;
      const int greal = grp < 2 ? grp * 16384 : 32768 + sl * 2048, gmeta = META0 + 64 * seq;
      attn_unit(qg, kvg, kr, o, lreal + qb * 256, 0, 256, greal + qb * 256, lmeta, lreal, gmeta, greal, head, 0, NT, nullptr, lds);
    } else {
      const int v = un - NUR, sp = v % NS, hs = v / NS, head = hs & 7, sl = hs >> 3;
      const int seq = grp < 2 ? grp : 2 + sl;
      const int lreal = sl * S, lmeta = 16384 + 64 * sl;
      const int greal = grp < 2 ? grp * 16384 : 32768 + sl * 2048, gmeta = META0 + 64 * seq;
      const int ta = (sp * NT) / NS, tb = ((sp + 1) * NT) / NS;
      const int pu = grp < 2 ? (grp * 8 + head) * 32 + sp : 512 + (sl * 8 + head) * 4 + sp;
      attn_unit(qg, kvg, kr, o, lmeta, 0, 0, gmeta, lmeta, lreal, gmeta, greal, head, ta, tb - ta, part + (size_t)pu * PART_STRIDE, lds);
    }
  }
}

DEVI void phase_attn_combine(const Params& p) {
  char* ar = p.ws + O_ARENA;
  const float* part = (const float*)(ar + A_PART); bf16_t* o = (bf16_t*)(ar + A_O);
  constexpr float C = ATT_SCALE * 1.4426950408889634f;
  const int gtid = blockIdx.x * 512 + otid(), nthr = gridDim.x * 512;
  for (int it = gtid; it < 10 * 8 * 16 * 128; it += nthr) {
    const int col = it & 127, row = (it >> 7) & 15, head = (it >> 11) & 7, seq = it >> 14;
    const int NS = seq < 2 ? 32 : 4;
    const float* pb = part + (size_t)(seq < 2 ? (seq * 8 + head) * 32 : 512 + ((seq - 2) * 8 + head) * 4) * PART_STRIDE;
    float M = -3.0e38f;
    for (int s2 = 0; s2 < NS; ++s2) M = fmaxf(M, pb[(size_t)s2 * PART_STRIDE + 2048 + row]);
    float num = 0.f, den = 0.f;
    for (int s2 = 0; s2 < NS; ++s2) {
      const float* q = pb + (size_t)s2 * PART_STRIDE;
      const float w = __builtin_amdgcn_exp2f((q[2048 + row] - M) * C);
      num += w * q[row * 128 + col]; den += w * q[2064 + row];
    }
    o[(size_t)(META0 + 64 * seq + 48 + row) * 1024 + head * 128 + col] = f2bf(num / den);
  }
}

#define XB_TMO      128
#define XB_XCNT(j)  (256  + 64 * (j))
#define XB_XSUB(j)  (1280 + 64 * (j))
#define XB_XGEN(j)  (2304 + 64 * (j))
#define XB_TOP      3328
#define XB_TOPGEN   3392
#define XCD_BAR_WORDS 3456
#define XB_SPIN_CAP (1u << 18)
#define LAS __attribute__((address_space(3)))

__device__ __forceinline__ unsigned xb_ld(unsigned* p)              { return __hip_atomic_load(p, __ATOMIC_RELAXED, __HIP_MEMORY_SCOPE_AGENT); }
__device__ __forceinline__ unsigned xb_add(unsigned* p, unsigned v) { return __hip_atomic_fetch_add(p, v, __ATOMIC_RELAXED, __HIP_MEMORY_SCOPE_AGENT); }
__device__ __forceinline__ unsigned xb_xcc_id() { return (unsigned)__builtin_amdgcn_s_getreg((3 << 11) | 20) & 0xFu; }
#define XB_SPIN(cond, bar) do { unsigned _sp = 0; while (cond) { __builtin_amdgcn_s_sleep(1); \
    if ((++_sp & 255u) == 0u) { if (xb_ld(&(bar)[XB_TMO])) break; if (_sp > XB_SPIN_CAP) { atomicAdd(&(bar)[XB_TMO], 1u); break; } } } } while (0)

struct XcdBarrier {
    unsigned* bar; unsigned x;
    volatile LAS unsigned* st;
};

__device__ __forceinline__ XcdBarrier xcd_barrier_post(unsigned* bar, volatile LAS unsigned* st) {
    XcdBarrier b; b.bar = bar; b.x = xb_xcc_id(); b.st = st;
    if (__builtin_amdgcn_workitem_id_x() == 0) (void)xb_add(&bar[XB_XCNT(b.x)], 1u);
    return b;
}
__device__ __forceinline__ void xcd_barrier_complete(unsigned* bar, unsigned x, unsigned& nloc, unsigned& nx) {
    const unsigned G = gridDim.x * gridDim.y * gridDim.z;
    unsigned sum, cnt, mine, sp = 0u;
    for (;;) {
        sum = 0u; cnt = 0u; mine = 0u;
#pragma unroll
        for (unsigned j = 0; j < 16; ++j) { const unsigned c = xb_ld(&bar[XB_XCNT(j)]); sum += c; cnt += (c > 0u) ? 1u : 0u; mine = (j == x) ? c : mine; }
        if (sum == G) break;
        __builtin_amdgcn_s_sleep(1);
        if ((++sp & 255u) == 0u) { if (xb_ld(&bar[XB_TMO])) break; if (sp > XB_SPIN_CAP) { atomicAdd(&bar[XB_TMO], 1u); break; } }
    }
    nloc = mine > 0u ? mine : 1u; nx = cnt > 0u ? cnt : 1u;
}

__device__ __forceinline__ void xcd_barrier(const XcdBarrier& b) {
    asm volatile("s_waitcnt vmcnt(0)" ::: "memory");
    __syncthreads();
    if (__builtin_amdgcn_workitem_id_x() == 0) {
        unsigned* bar = b.bar;
        __builtin_amdgcn_s_waitcnt(0);
        unsigned nloc = b.st[0], nx = b.st[1];
        if (nloc == 0u) { xcd_barrier_complete(bar, b.x, nloc, nx); b.st[0] = nloc; b.st[1] = nx; }
        const unsigned old = xb_add(&bar[XB_XSUB(b.x)], 1u);
        const unsigned gen = old / nloc;
        if (old + 1u == (gen + 1u) * nloc) {
            __builtin_amdgcn_fence(__ATOMIC_RELEASE, "agent");
            asm volatile("s_waitcnt vmcnt(0)" ::: "memory");
            const unsigned og = xb_add(&bar[XB_TOP], 1u);
            const unsigned tg = og / nx;
            if (og + 1u == (tg + 1u) * nx) xb_add(&bar[XB_TOPGEN], 1u);
            else XB_SPIN(xb_ld(&bar[XB_TOPGEN]) == tg, bar);
            __builtin_amdgcn_fence(__ATOMIC_ACQUIRE, "agent");
            xb_add(&bar[XB_XGEN(b.x)], 1u);
            asm volatile("s_waitcnt vmcnt(0)" ::: "memory");
        } else {
            XB_SPIN(xb_ld(&bar[XB_XGEN(b.x)]) == gen, bar);
            __builtin_amdgcn_fence(__ATOMIC_ACQUIRE, "agent");
            asm volatile("s_waitcnt vmcnt(0)" ::: "memory");
        }
    }
    __syncthreads();
}


DEVI void run_group(const Params& p, int gi, char* lds) {
  char* ar = p.ws + O_ARENA;
  if (gi == 36) { phase_final_norm(p); return; }
  const int L = gi >= 18 ? 1 : 0, st = gi - 18 * L;
  switch (st) {
    case 0:
      phase_convert(p, L, lds);
      phase_s5prep1(p, L);
      if (L == 0) phase_rope_table(p);
      phase_norm(p, p.norm_mix + L * 1024, (bf16_t*)(ar + A_XN1), L == 0);
      break;
    case 1: phase_s5prep2(p, L); phase_proj(p, lds); break;
    case 2: phase_s5prep3(p, L); phase_latent_rstd(p); phase_s5a1(p, lds); break;
    case 3: phase_carry(p); break;
    case 4: phase_s5a3(p, lds); break;
    case 5: phase_glu(p, L, lds); break;
    case 6: case 8: case 10: phase_qkv(p, (st - 6) >> 1, lds); break;
    case 7: case 9: case 11: phase_attn(p, (st - 7) >> 1, lds); break;
    case 12: phase_attn_combine(p); phase_norm(p, p.norm_mix + L * 1024, (bf16_t*)(ar + A_XN2), L == 0); break;
    case 13: phase_merge(p, lds); break;
    case 14: phase_resid_gemm(p, (const bf16_t*)(ar + A_MERGED), 1024, (const bf16_t*)(p.ws + O_WMIX), L == 0, lds); break;
    case 15: phase_norm(p, p.norm_ffn + L * 1024, (bf16_t*)(ar + A_XN3), false, LDX); break;
    case 16: phase_ffn_up(p, lds); break;
    default: phase_resid_gemm(p, (const bf16_t*)(ar + A_HID), 2816, (const bf16_t*)(p.ws + O_WD), false, lds); break;
  }
}


#ifndef DBG_GROUPS
#define DBG_GROUPS 0
#endif
#ifndef DBG_OFF
#define DBG_OFF 0
#endif
#ifndef DBG_N
#define DBG_N 1
#endif
__global__ __launch_bounds__(512) void dbg_dump_kernel(Params p, size_t off, unsigned n) {
  const bf16_t* b = (const bf16_t*)(p.ws + off);
  for (size_t i = (size_t)blockIdx.x * 512 + threadIdx.x; i < (size_t)NREAL * 1024; i += (size_t)gridDim.x * 512)
    p.out[i] = bf2f(b[(unsigned)i % n]);
}
#ifndef MULTI_LAUNCH
#define MULTI_LAUNCH 0
#endif

__global__ __launch_bounds__(512, 1) void mega_fwd(Params p, int g_begin, int g_end) {
  extern __shared__ __attribute__((aligned(16))) char lds[];
  volatile LAS unsigned* xst = (volatile LAS unsigned*)(LAS char*)(lds + LDS_BYTES - 16);
  if (__builtin_amdgcn_workitem_id_x() == 0) { xst[0] = 0u; xst[1] = 0u; }
  __syncthreads();
  const XcdBarrier xb = xcd_barrier_post((unsigned*)(p.ws + O_BAR), xst);
#pragma unroll 1
  for (int gi = g_begin; gi < g_end; ++gi) {
    run_group(p, gi, lds);
    if (gi + 1 < g_end) {
      if (gi == g_begin) { asm volatile("s_waitcnt vmcnt(0) lgkmcnt(0)" ::: "memory"); cg::this_grid().sync(); }
      else xcd_barrier(xb);
    }
  }
}

extern "C" void kernel_launch(void* const* d_in, const int* in_sizes, int n_in, void* d_out, int out_size, void* d_ws, size_t ws_size,
                              hipStream_t stream) {
  static int grid_blocks = 0;
  if (!grid_blocks) {
    if (ws_size < WS_NEED) { fprintf(stderr, "kernel_launch: workspace too small: %zu < %zu\n", ws_size, (size_t)WS_NEED); return; }
    if (hipFuncSetAttribute((const void*)mega_fwd, hipFuncAttributeMaxDynamicSharedMemorySize, LDS_BYTES) != hipSuccess) {
      fprintf(stderr, "kernel_launch: hipFuncSetAttribute failed\n"); return; }
    int dev = 0, cus = 0, per_cu = 0;
    hipGetDevice(&dev);
    hipDeviceGetAttribute(&cus, hipDeviceAttributeMultiprocessorCount, dev);
    hipOccupancyMaxActiveBlocksPerMultiprocessor(&per_cu, mega_fwd, 512, LDS_BYTES);
    if (per_cu < 1) { fprintf(stderr, "kernel_launch: occupancy query returned %d\n", per_cu); return; }
    grid_blocks = cus;
  }
  Params p{};
  const float** f = (const float**)&p;
  for (int i = 0; i < 27; ++i) f[i] = (const float*)d_in[i];
  p.out = (float*)d_out; p.ws = (char*)d_ws;
  for (int i = 0; i < 32; ++i) { const float pw = (float)pow(10000.0, (double)i / 32.0); p.inv[i] = 1.0f / pw; }
  int gb = 0, ge = 37;
  if (MULTI_LAUNCH) {
    const int ng = DBG_GROUPS > 0 ? DBG_GROUPS : 37;
    for (int g = 0; g < ng; ++g) hipLaunchKernelGGL(mega_fwd, dim3(grid_blocks), dim3(512), LDS_BYTES, stream, p, g, g + 1);
    if (DBG_GROUPS > 0) hipLaunchKernelGGL(dbg_dump_kernel, dim3(2048), dim3(512), 0, stream, p, (size_t)(DBG_OFF), (unsigned)(DBG_N));
    return;
  }
  hipMemsetAsync((char*)d_ws + O_BAR, 0, 4096 * 4, stream);
  void* args[] = {&p, &gb, &ge};
  hipError_t e = hipLaunchCooperativeKernel((const void*)mega_fwd, dim3(grid_blocks), dim3(512), args, LDS_BYTES, stream);
  if (e != hipSuccess) fprintf(stderr, "cooperative launch failed: %s (grid %d)\n", hipGetErrorString(e), grid_blocks);
}
```

```cpp
#include <hip/hip_runtime.h>
#include <hip/hip_cooperative_groups.h>
#include <cstdio>
#include <cstdint>
#include <cmath>
namespace cg = cooperative_groups;

typedef unsigned short bf16_t;
typedef short bf16x8 __attribute__((ext_vector_type(8)));
typedef short s16x4 __attribute__((ext_vector_type(4)));
typedef float f32x16 __attribute__((ext_vector_type(16)));
typedef float f32x4 __attribute__((ext_vector_type(4)));
typedef unsigned u32x4 __attribute__((ext_vector_type(4)));
typedef unsigned u32x2 __attribute__((ext_vector_type(2)));
#define DEVI __device__ __forceinline__
#define SBAR() __builtin_amdgcn_sched_barrier(0)

constexpr int NREAL = 49152, META0 = 49152, MPAD = 49920, NTILE_M = 195;
constexpr int NCHUNK = 1560, NCHUNK_PAD = 1792;
constexpr int QG_ROWS = 16896;
constexpr int LDS_BYTES = 150528;

struct Params {
  const float* x_prompt; const float* x_sample; const float* meta; const float* norm_mix; const float* w_in;
  const float* lam_re; const float* lam_im; const float* log_dt; const float* b_re; const float* b_im; const float* c_re; const float* c_im;
  const float* ssm_d; const float* w_glu; const float* b_glu; const float* w_ssm_out; const float* norm_cq; const float* w_uq;
  const float* norm_ckv; const float* w_ukv; const float* w_attn_out; const float* w_mix_out; const float* norm_ffn;
  const float* w_ffn_gate; const float* w_ffn_up; const float* w_ffn_down; const float* norm_final;
  float* out; char* ws;
  float inv[32];
};

constexpr size_t al(size_t x) { return (x + 255) & ~size_t(255); }
constexpr size_t O_WIN = 0;
constexpr size_t O_WG = O_WIN + al((size_t)1280 * 1024 * 2);
constexpr size_t O_WGLU = O_WG + al((size_t)2048 * 1024 * 2);
constexpr size_t O_WSSM = O_WGLU + al((size_t)512 * 512 * 2);
constexpr size_t O_WUQ = O_WSSM + al((size_t)1024 * 512 * 2);
constexpr size_t O_WUKV = O_WUQ + al((size_t)1536 * 384 * 2);
constexpr size_t O_WATTN = O_WUKV + al((size_t)2048 * 256 * 2);
constexpr size_t O_WMIX = O_WATTN + al((size_t)1024 * 1024 * 2);
constexpr size_t O_WGU = O_WMIX + al((size_t)1024 * 1024 * 2);
constexpr int LDX = 1088;
constexpr size_t O_WD = O_WGU + al((size_t)5632 * LDX * 2);
constexpr size_t O_APOW = O_WD + al((size_t)1024 * 2816 * 2);
constexpr size_t O_BBAR = O_APOW + al((size_t)2 * 32 * 33 * 64 * 8);
constexpr size_t O_KFB = O_BBAR + al((size_t)2 * 32 * 64 * 16 * 8);
constexpr size_t O_W1T = O_KFB + al((size_t)2 * 32 * 32 * 256 * 4);
constexpr size_t O_W3T = O_W1T + al((size_t)32 * 256 * 512 * 2);
constexpr size_t O_ROPE = O_W3T + al((size_t)32 * 512 * 768 * 2);
constexpr size_t O_HMETA = O_ROPE + al((size_t)16400 * 32 * 8);
constexpr size_t O_BAR = O_HMETA + al((size_t)768 * 1024 * 4);
constexpr size_t O_RSTD = O_BAR + al((size_t)4096 * 4);
constexpr size_t O_ARENA = O_RSTD + al((size_t)49920 * 2 * 4);
constexpr size_t A_Z2 = 0;
constexpr size_t A_CARRY = 0;
constexpr size_t A_O = 51118080;
constexpr size_t A_XN1 = A_O;
constexpr size_t A_QG = 153354240;
constexpr size_t A_U = A_QG;
constexpr size_t A_KVG = 205258752;
constexpr size_t A_SLOC = A_KVG;
constexpr size_t A_Z1 = A_KVG;
constexpr size_t A_CQ = 274464768;
constexpr size_t A_CKV = 312803328;
constexpr size_t A_KR = 338362368;
constexpr size_t A_XN2 = A_QG;
constexpr size_t A_MERGED = 255590400;
constexpr size_t A_XN3 = 0;
constexpr size_t A_HID = 108625920;
constexpr size_t ARENA_SIZE = 389775360;
constexpr size_t WS_NEED = O_ARENA + ARENA_SIZE;

DEVI int otid() { int t = __builtin_amdgcn_workitem_id_x(); asm volatile("" : "+v"(t)); return t; }
DEVI bf16_t f2bf(float f) { unsigned u = __float_as_uint(f); u += 0x7fffu + ((u >> 16) & 1u); return (bf16_t)(u >> 16); }
DEVI float bf2f(bf16_t b) { return __uint_as_float(((unsigned)b) << 16); }
typedef __bf16 bf16x2_t __attribute__((ext_vector_type(2)));
DEVI unsigned cvtpk(float lo, float hi) { bf16x2_t v; v[0] = (__bf16)lo; v[1] = (__bf16)hi; return __builtin_bit_cast(unsigned, v); }
DEVI int crow(int r, int hi) { return (r & 3) + 8 * (r >> 2) + 4 * hi; }
DEVI float sigmoidf_(float x) { return __builtin_amdgcn_rcpf(1.f + __expf(-x)); }
DEVI int pos_of_row(int m) {
  if (m < 32768) return (m & 16383) + 16;
  if (m < NREAL) return ((m - 32768) & 2047) + 16;
  int lr = (m - META0) & 63; return lr >= 48 ? lr - 48 : 0;
}
DEVI f32x4 unpack4(u32x2 w) { f32x4 v; v[0] = __uint_as_float(w.x << 16); v[1] = __uint_as_float(w.x & 0xffff0000u); v[2] = __uint_as_float(w.y << 16); v[3] = __uint_as_float(w.y & 0xffff0000u); return v; }
DEVI bool is_pad_lr(int lr) { return lr >= 640 || (lr & 63) < 48; }
template <int MI> DEVI void zero_acc(f32x16 (&acc)[MI][2]) {
#pragma unroll
  for (int mi = 0; mi < MI; ++mi)
#pragma unroll
    for (int ni = 0; ni < 2; ++ni)
#pragma unroll
      for (int r = 0; r < 16; ++r) acc[mi][ni][r] = 0.f;
}
#define FOR_MN(mi, ni) _Pragma("unroll") for (int mi = 0; mi < MIV; ++mi) _Pragma("unroll") for (int ni = 0; ni < 2; ++ni)
#define FOR_R(r) _Pragma("unroll") for (int r = 0; r < 16; ++r)
#define FOR_ACC(mi, ni, r) _Pragma("unroll") for (int mi = 0; mi < MIV; ++mi) _Pragma("unroll") for (int ni = 0; ni < 2; ++ni) _Pragma("unroll") for (int r = 0; r < 16; ++r)

template <int MI> struct GStage { u32x4 ra0[MI], rb0[4], ra1[MI], rb1[4]; };
#define GEMM_ADDR()                                                                                                                 \
  const int tid = otid(), lane = tid & 63, wid = tid >> 6, r32 = lane & 31, hi = lane >> 5;                                        \
  const int wm = wid >> 2, wn = wid & 3;                                                                                            \
  const int lrow = tid >> 3, lslot = tid & 7;                                                                                       \
  unsigned aoff[MI];                                                                                                                \
  _Pragma("unroll") for (int i = 0; i < MI; ++i) { int r = lrow + 64 * i; r = r < arows ? r : arows - 1; aoff[i] = (unsigned)(r * lda) * 2u; }  \
  const unsigned boff = (unsigned)(lrow * ldb + lslot * 8) * 2u;                                                                    \
  const int pmask = (1 << pl) - 1;                                                                                                  \
  const int nk = K >> 6;
#define GLOAD(RA, RB, kt_) do { const int k_ = (kt_) * 64 + lslot * 8; const unsigned ko_ = (unsigned)(((k_ >> pl) * ps) + (k_ & pmask)) * 2u;  \
    _Pragma("unroll") for (int i = 0; i < MI; ++i) RA[i] = *(const u32x4*)((const char*)A + (aoff[i] + ko_));                       \
    _Pragma("unroll") for (int i = 0; i < 4; ++i) RB[i] = *(const u32x4*)((const char*)B + (boff + (unsigned)(64 * i * ldb + (kt_) * 64) * 2u)); } while (0)

template <int MI, int PF = 1>
DEVI void gemm_prefetch(GStage<MI>& st, const bf16_t* __restrict__ A, int lda, int arows, int pl, int ps,
                        const bf16_t* __restrict__ B, int ldb, int K) {
  GEMM_ADDR();
  (void)hi; (void)wm; (void)wn; (void)r32;
  GLOAD(st.ra0, st.rb0, 0);
  if constexpr (PF == 2) { if (nk > 1) GLOAD(st.ra1, st.rb1, 1); }
}

template <int MI, int PF = 1, int KSBT = 0>
DEVI void gemm_main(f32x16 (&acc)[MI][2], GStage<MI>& st, const bf16_t* __restrict__ A, int lda, int arows, int pl, int ps,
                    const bf16_t* __restrict__ B, int ldb, int K, char* lds) {
  GEMM_ADDR();
  const int wofs = lrow * 128 + ((lslot ^ ((lrow >> 1) & 7)) << 4);
#define LWRITE(b_, RA, RB) do { char* As_ = lds + (b_) * 32768 + wofs; char* Bs_ = lds + 65536 + (b_) * 32768 + wofs;            \
    _Pragma("unroll") for (int i = 0; i < MI; ++i) *(u32x4*)(As_ + i * 8192) = RA[i];                                              \
    _Pragma("unroll") for (int i = 0; i < 4; ++i) *(u32x4*)(Bs_ + i * 8192) = RB[i]; } while (0)
  const int swz = (r32 >> 1) & 7;
  const int abase = (wm * (32 * MI) + r32) * 128, bbase = 65536 + (wn * 64 + r32) * 128;
  constexpr int KSB = KSBT ? KSBT : (MI == 2 ? 2 : 1);
  constexpr int MHF = MI == 4 ? 2 : MI;
#define COMPUTE(b_) do { const char* Ab_ = lds + (b_) * 32768 + abase; const char* Bb_ = lds + (b_) * 32768 + bbase;              \
    _Pragma("unroll") for (int kb = 0; kb < 4; kb += KSB) _Pragma("unroll") for (int mh = 0; mh < MI; mh += MHF) {                 \
      bf16x8 fa_[KSB][MHF], fb_[KSB][2];                                                                                           \
      _Pragma("unroll") for (int k2 = 0; k2 < KSB; ++k2) { const int so = (((kb + k2) * 2 + hi) ^ swz) << 4;                       \
        _Pragma("unroll") for (int mi = 0; mi < MHF; ++mi) fa_[k2][mi] = *(const bf16x8*)(Ab_ + (mh + mi) * 4096 + so);            \
        _Pragma("unroll") for (int ni = 0; ni < 2; ++ni) fb_[k2][ni] = *(const bf16x8*)(Bb_ + ni * 4096 + so); }                   \
      SBAR();                                                                                                                      \
      _Pragma("unroll") for (int k2 = 0; k2 < KSB; ++k2) _Pragma("unroll") for (int mi = 0; mi < MHF; ++mi)                        \
        _Pragma("unroll") for (int ni = 0; ni < 2; ++ni)                                                                           \
          acc[mh + mi][ni] = __builtin_amdgcn_mfma_f32_32x32x16_bf16(fa_[k2][mi], fb_[k2][ni], acc[mh + mi][ni], 0, 0, 0);         \
      SBAR(); } } while (0)
  if constexpr (PF == 2) {
    __syncthreads(); LWRITE(0, st.ra0, st.rb0); __syncthreads();
#pragma unroll 1
    for (int kt = 0; kt < nk; kt += 2) {
      if (kt + 2 < nk) GLOAD(st.ra0, st.rb0, kt + 2);
      COMPUTE(0);
      if (kt + 1 < nk) LWRITE(1, st.ra1, st.rb1);
      __syncthreads();
      if (kt + 1 >= nk) break;
      if (kt + 3 < nk) GLOAD(st.ra1, st.rb1, kt + 3);
      COMPUTE(1);
      if (kt + 2 < nk) LWRITE(0, st.ra0, st.rb0);
      __syncthreads();
    }
  } else {
    __syncthreads(); LWRITE(0, st.ra0, st.rb0);
    if (nk > 1) GLOAD(st.ra0, st.rb0, 1);
    __syncthreads();
#pragma unroll 1
    for (int kt = 0; kt < nk; ++kt) {
      const int b = kt & 1;
      if (kt + 1 < nk) {
        LWRITE(b ^ 1, st.ra0, st.rb0);
        if (kt + 2 < nk) GLOAD(st.ra0, st.rb0, kt + 2);
      }
      COMPUTE(b);
      __syncthreads();
    }
  }
#undef LWRITE
#undef COMPUTE
}

template <int MI, int PF = 1>
DEVI void gemm_acc(f32x16 (&acc)[MI][2], const bf16_t* __restrict__ A, int lda, int arows, int pl, int ps,
                   const bf16_t* __restrict__ B, int ldb, int K, char* lds) {
  GStage<MI> st;
  gemm_prefetch<MI, PF>(st, A, lda, arows, pl, ps, B, ldb, K);
  gemm_main<MI, PF, (MI == 2 ? 4 : 0)>(acc, st, A, lda, arows, pl, ps, B, ldb, K, lds);
}

DEVI bool unit_xcd(int i, int nM, int nN, int& mt, int& nt) {
  const int x = blockIdx.x & 7, lb = blockIdx.x >> 3, nb = gridDim.x >> 3;
  const int m0 = (x * nM) >> 3, m1 = ((x + 1) * nM) >> 3;
  const int li = lb + nb * i;
  if (li >= (m1 - m0) * nN) return false;
  mt = m0 + li / nN; nt = li % nN; return true;
}

DEVI bool unit_xcd_cb(int i, int nM, int nN, int CB, int& mt, int& nt) {
  const int x = blockIdx.x & 7, lb = blockIdx.x >> 3, nb = gridDim.x >> 3;
  const int m0 = (x * nM) >> 3, m1 = ((x + 1) * nM) >> 3, Mx = m1 - m0;
  const int li = lb + nb * i;
  const int nbk = nN / CB, rem = nN - nbk * CB, full = nbk * CB * Mx;
  if (li < full) { const int b = li / (CB * Mx), r = li - b * (CB * Mx); mt = m0 + r / CB; nt = b * CB + r % CB; return true; }
  const int l2 = li - full;
  if (rem == 0 || l2 >= rem * Mx) return false;
  mt = m0 + l2 / rem; nt = nbk * CB + l2 % rem; return true;
}

DEVI void conv_job(const float* __restrict__ src, int K, int N, int ncol0, int ncols, bf16_t* __restrict__ dst, int mode,
                   const float* __restrict__ kscale, int wgid, int nwaves, char* ldsw, int& joff, int dld = 0) {
  if (dld == 0) dld = K;
  const int ntn = ncols >> 6, ntk = K >> 6, lane = otid() & 63;
  bf16_t* t = (bf16_t*)ldsw;
  int start = wgid - (joff % nwaves); if (start < 0) start += nwaves;
  for (int ti = start; ti < ntn * ntk; ti += nwaves) {
    const int tn = ti % ntn, tk = ti / ntn, n0 = tn * 64, k0 = tk * 64;
#pragma unroll 16
    for (int i = 0; i < 64; ++i) {
      float v = src[(long)(k0 + i) * N + ncol0 + n0 + lane];
      if (kscale) v *= kscale[k0 + i];
      t[lane * 66 + i] = f2bf(v);
    }
    __builtin_amdgcn_wave_barrier();
    asm volatile("s_waitcnt lgkmcnt(0)" ::: "memory");
    for (int it = 0; it < 32; ++it) {
      const int row = it * 2 + (lane >> 5), c2 = (lane & 31) * 2;
      const unsigned v = *(const unsigned*)&t[row * 66 + c2];
      const int n = n0 + row;
      const int orow = mode == 0 ? n : ((n >> 5) * 64 + (n & 31) + (mode == 2 ? 32 : 0));
      *(unsigned*)&dst[(long)orow * dld + k0 + c2] = v;
    }
    __builtin_amdgcn_wave_barrier();
    asm volatile("s_waitcnt lgkmcnt(0)" ::: "memory");
  }
  joff += ntn * ntk;
}

DEVI void phase_convert(const Params& p, int L, char* lds) {
  char* ws = p.ws;
  const int wgid = blockIdx.x * 8 + (otid() >> 6), nwaves = gridDim.x * 8;
  char* ldsw = lds + (otid() >> 6) * 8448;
  int joff = 0;
  conv_job(p.w_in + (size_t)L * 1024 * 3264, 1024, 3264, 0, 1216, (bf16_t*)(ws + O_WIN), 0, nullptr, wgid, nwaves, ldsw, joff);
  conv_job(p.w_in + (size_t)L * 1024 * 3264, 1024, 3264, 1216, 2048, (bf16_t*)(ws + O_WG), 0, nullptr, wgid, nwaves, ldsw, joff);
  conv_job(p.w_glu + (size_t)L * 512 * 512, 512, 512, 0, 512, (bf16_t*)(ws + O_WGLU), 0, nullptr, wgid, nwaves, ldsw, joff);
  conv_job(p.w_ssm_out + (size_t)L * 512 * 1024, 512, 1024, 0, 1024, (bf16_t*)(ws + O_WSSM), 0, nullptr, wgid, nwaves, ldsw, joff);
  conv_job(p.w_uq + (size_t)L * 384 * 1536, 384, 1536, 0, 1536, (bf16_t*)(ws + O_WUQ), 0, p.norm_cq + L * 384, wgid, nwaves, ldsw, joff);
  conv_job(p.w_ukv + (size_t)L * 256 * 2048, 256, 2048, 0, 2048, (bf16_t*)(ws + O_WUKV), 0, p.norm_ckv + L * 256, wgid, nwaves, ldsw, joff);
  conv_job(p.w_attn_out + (size_t)L * 1024 * 1024, 1024, 1024, 0, 1024, (bf16_t*)(ws + O_WATTN), 0, nullptr, wgid, nwaves, ldsw, joff);
  conv_job(p.w_mix_out + (size_t)L * 1024 * 1024, 1024, 1024, 0, 1024, (bf16_t*)(ws + O_WMIX), 0, nullptr, wgid, nwaves, ldsw, joff);
  conv_job(p.w_ffn_gate + (size_t)L * 1024 * 2816, 1024, 2816, 0, 2816, (bf16_t*)(ws + O_WGU), 1, nullptr, wgid, nwaves, ldsw, joff, LDX);
  conv_job(p.w_ffn_up + (size_t)L * 1024 * 2816, 1024, 2816, 0, 2816, (bf16_t*)(ws + O_WGU), 2, nullptr, wgid, nwaves, ldsw, joff, LDX);
  conv_job(p.w_ffn_down + (size_t)L * 2816 * 1024, 2816, 1024, 0, 1024, (bf16_t*)(ws + O_WD), 0, nullptr, wgid, nwaves, ldsw, joff);
  unsigned* z = (unsigned*)(ws + O_WIN + (size_t)1216 * 1024 * 2);
  const int zt = otid();
#pragma unroll 1
  for (int b = blockIdx.x; b < 64; b += gridDim.x) z[b * 512 + zt] = 0u;
}

DEVI void sincos_rev(double ang, float& c, float& s) {
  double t = ang * 0.15915494309189535; t -= rint(t);
  const float tf = (float)t;
  c = __builtin_amdgcn_cosf(tf); s = __builtin_amdgcn_sinf(tf);
}

DEVI void phase_s5prep1(const Params& p, int L) {
  char* ws = p.ws;
  float2* Apow = (float2*)(ws + O_APOW); float2* Bbar = (float2*)(ws + O_BBAR);
  const int gtid = blockIdx.x * 512 + otid(), nthr = gridDim.x * 512;
  for (int idx = gtid; idx < 4096; idx += nthr) {
    const int pp = idx & 63, g = (idx >> 6) & 31, dir = idx >> 11;
    const int pg = (L * 2 + dir) * 32 + g;
    const float lr = p.lam_re[pg * 64 + pp], li = p.lam_im[pg * 64 + pp];
    const float dt = expf(p.log_dt[pg]);
    float ar = 1.f, ai = 0.f;
    for (int d = 0; d <= 32; ++d) {
      float c, s; sincos_rev((double)li * (double)dt * (double)d, c, s);
      const float mag = expf(lr * dt * (float)d);
      Apow[((dir * 32 + g) * 33 + d) * 64 + pp] = make_float2(mag * c, mag * s);
      if (d == 1) { ar = mag * c; ai = mag * s; }
    }
    const float nr = ar - 1.f, den = lr * lr + li * li;
    const float sr = (nr * lr + ai * li) / den, si = (ai * lr - nr * li) / den;
    for (int h = 0; h < 16; ++h) {
      const float br = p.b_re[(size_t)(pg * 64 + pp) * 16 + h], bi = p.b_im[(size_t)(pg * 64 + pp) * 16 + h];
      Bbar[((dir * 32 + g) * 64 + pp) * 16 + h] = make_float2(sr * br - si * bi, sr * bi + si * br);
    }
  }
}

DEVI void phase_s5prep2(const Params& p, int L) {
  char* ws = p.ws;
  const float2* Apow = (const float2*)(ws + O_APOW); const float2* Bbar = (const float2*)(ws + O_BBAR);
  float* KFB = (float*)(ws + O_KFB); bf16_t* W1T = (bf16_t*)(ws + O_W1T); bf16_t* W3T = (bf16_t*)(ws + O_W3T);
  const int gtid = blockIdx.x * 512 + otid(), nthr = gridDim.x * 512;
  for (int idx = gtid; idx < 2 * 32 * 32 * 256; idx += nthr) {
    const int hh = idx & 255, h = hh >> 4, h2 = hh & 15, d = (idx >> 8) & 31, g = (idx >> 13) & 31, dir = idx >> 18;
    const int pg = (L * 2 + dir) * 32 + g;
    const float* cr = p.c_re + (size_t)(pg * 16 + h) * 64; const float* ci = p.c_im + (size_t)(pg * 16 + h) * 64;
    const float2* A = Apow + ((dir * 32 + g) * 33 + d) * 64; const float2* Bb = Bbar + ((dir * 32 + g) * 64) * 16 + h2;
    float val = 0.f;
    for (int pp = 0; pp < 64; ++pp) {
      const float2 a = A[pp], b = Bb[pp * 16];
      const float tr = cr[pp] * a.x - ci[pp] * a.y, ti = cr[pp] * a.y + ci[pp] * a.x;
      val += tr * b.x - ti * b.y;
    }
    KFB[idx] = val;
  }
  for (int idx = gtid; idx < 32 * 256 * 512; idx += nthr) {
    const int k = idx & 511, n = (idx >> 9) & 255, g = idx >> 17;
    const int dir = n >> 7, reim = (n >> 6) & 1, pp = n & 63, j = k >> 4, h2 = k & 15;
    const int e = dir == 0 ? 31 - j : j;
    const float2 a = Apow[((dir * 32 + g) * 33 + e) * 64 + pp], b = Bbar[((dir * 32 + g) * 64 + pp) * 16 + h2];
    const float vr = a.x * b.x - a.y * b.y, vi = a.x * b.y + a.y * b.x;
    W1T[idx] = f2bf(reim ? vi : vr);
  }
  for (int idx = gtid; idx < 32 * 512 * 256; idx += nthr) {
    const int kk = idx & 255, n = (idx >> 8) & 511, g = idx >> 17;
    const int dir = kk >> 7, reim = (kk >> 6) & 1, pp = kk & 63, j = n >> 4, h = n & 15;
    const int e = dir == 0 ? j + 1 : 32 - j;
    const int pg = (L * 2 + dir) * 32 + g;
    const float cr = p.c_re[(size_t)(pg * 16 + h) * 64 + pp], ci = p.c_im[(size_t)(pg * 16 + h) * 64 + pp];
    const float2 a = Apow[((dir * 32 + g) * 33 + e) * 64 + pp];
    const float vr = cr * a.x - ci * a.y, vi = cr * a.y + ci * a.x;
    W3T[(size_t)(g * 512 + n) * 768 + 512 + kk] = f2bf(reim ? -vi : vr);
  }
}

DEVI void phase_s5prep3(const Params& p, int L) {
  char* ws = p.ws;
  const float* KFB = (const float*)(ws + O_KFB); bf16_t* W3T = (bf16_t*)(ws + O_W3T);
  const int gtid = blockIdx.x * 512 + otid(), nthr = gridDim.x * 512;
  for (int idx = gtid; idx < 32 * 512 * 512; idx += nthr) {
    const int k = idx & 511, n = (idx >> 9) & 511, g = idx >> 18;
    const int s = k >> 4, h2 = k & 15, j = n >> 4, h = n & 15;
    float val = 0.f;
    if (s <= j) val += KFB[((0 * 32 + g) * 32 + (j - s)) * 256 + h * 16 + h2];
    if (s >= j) val += KFB[((1 * 32 + g) * 32 + (s - j)) * 256 + h * 16 + h2];
    if (s == j && h == h2) val += p.ssm_d[L * 512 + g * 16 + h];
    W3T[(size_t)(g * 512 + n) * 768 + k] = f2bf(val);
  }
}

DEVI void phase_rope_table(const Params& p) {
  float2* rope = (float2*)(p.ws + O_ROPE);
  const int gtid = blockIdx.x * 512 + otid(), nthr = gridDim.x * 512;
  for (int idx = gtid; idx < 16400 * 32; idx += nthr) {
    const int i = idx & 31, pos = idx >> 5;
    const float ang = (float)pos * p.inv[i];
    float c, s; sincos_rev((double)ang, c, s);
    rope[idx] = make_float2(c, s);
  }
}

DEVI const float* hrow_c(const Params& p, int m) { return m < NREAL ? p.out + (size_t)m * 1024 : (const float*)(p.ws + O_HMETA) + (size_t)(m - META0) * 1024; }

DEVI void phase_norm(const Params& p, const float* __restrict__ gain, bf16_t* __restrict__ xn, bool from_input, int ld = 1024) {
  const int lane = otid() & 63;
  const int wgid = blockIdx.x * 8 + (otid() >> 6), nwaves = gridDim.x * 8;
  f32x4 g4[4];
#pragma unroll
  for (int i = 0; i < 4; ++i) g4[i] = *(const f32x4*)(gain + i * 256 + lane * 4);
  for (int m0 = wgid; m0 < MPAD; m0 += 2 * nwaves) {
    f32x4 v[2][4]; bool val[2];
#pragma unroll
    for (int j = 0; j < 2; ++j) {
      const int m = m0 + j * nwaves; val[j] = m < MPAD;
      const float* src = nullptr; bool zero = !val[j];
      if (val[j]) {
        if (from_input) {
          if (m < 32768) src = p.x_prompt + (size_t)m * 1024;
          else if (m < NREAL) src = p.x_sample + (size_t)(m - 32768) * 1024;
          else { const int lr = m - META0; if (is_pad_lr(lr)) zero = true; else src = p.meta + (size_t)((lr & 63) - 48) * 1024; }
        } else src = hrow_c(p, m);
      }
#pragma unroll
      for (int i = 0; i < 4; ++i) { if (zero) v[j][i] = (f32x4){0.f, 0.f, 0.f, 0.f}; else v[j][i] = *(const f32x4*)(src + i * 256 + lane * 4); }
    }
#pragma unroll
    for (int j = 0; j < 2; ++j) {
      if (!val[j]) continue;
      const int m = m0 + j * nwaves;
      float ss = 0.f;
#pragma unroll
      for (int i = 0; i < 4; ++i) ss += v[j][i][0] * v[j][i][0] + v[j][i][1] * v[j][i][1] + v[j][i][2] * v[j][i][2] + v[j][i][3] * v[j][i][3];
#pragma unroll
      for (int o = 32; o >= 1; o >>= 1) ss += __shfl_xor(ss, o);
      const float rstd = rsqrtf(ss * (1.f / 1024.f) + 1e-6f);
#pragma unroll
      for (int i = 0; i < 4; ++i) {
        u32x2 w; w.x = cvtpk(v[j][i][0] * rstd * g4[i][0], v[j][i][1] * rstd * g4[i][1]); w.y = cvtpk(v[j][i][2] * rstd * g4[i][2], v[j][i][3] * rstd * g4[i][3]);
        *(u32x2*)(xn + (size_t)m * ld + i * 256 + lane * 4) = w;
      }
      if (from_input && m >= META0) {
        float* hm = (float*)(p.ws + O_HMETA) + (size_t)(m - META0) * 1024;
#pragma unroll
        for (int i = 0; i < 4; ++i) *(f32x4*)(hm + i * 256 + lane * 4) = v[j][i];
      }
    }
  }
}

DEVI void phase_final_norm(const Params& p) {
  const int lane = otid() & 63;
  const int wgid = blockIdx.x * 8 + (otid() >> 6), nwaves = gridDim.x * 8;
  f32x4 g4[4];
#pragma unroll
  for (int i = 0; i < 4; ++i) g4[i] = *(const f32x4*)(p.norm_final + i * 256 + lane * 4);
  for (int m = wgid; m < NREAL; m += nwaves) {
    float* row = p.out + (size_t)m * 1024;
    f32x4 v[4]; float ss = 0.f;
#pragma unroll
    for (int i = 0; i < 4; ++i) { v[i] = *(const f32x4*)(row + i * 256 + lane * 4); ss += v[i][0] * v[i][0] + v[i][1] * v[i][1] + v[i][2] * v[i][2] + v[i][3] * v[i][3]; }
#pragma unroll
    for (int o = 32; o >= 1; o >>= 1) ss += __shfl_xor(ss, o);
    const float rstd = rsqrtf(ss * (1.f / 1024.f) + 1e-6f);
#pragma unroll
    for (int i = 0; i < 4; ++i) { f32x4 w = v[i] * rstd * g4[i]; *(f32x4*)(row + i * 256 + lane * 4) = w; }
  }
}

DEVI void phase_carry(const Params& p) {
  char* ws = p.ws;
  const float2* Apow = (const float2*)(ws + O_APOW);
  const float* Sloc = (const float*)(ws + O_ARENA + A_SLOC); bf16_t* carry = (bf16_t*)(ws + O_ARENA + A_CARRY);
  const int gtid = blockIdx.x * 512 + otid(), nthr = gridDim.x * 512;
  for (int idx = gtid; idx < 10 * 32 * 2 * 64; idx += nthr) {
    const int pp = idx & 63, dir = (idx >> 6) & 1, g = (idx >> 7) & 31, seq = idx >> 12;
    const float2 aT = Apow[((dir * 32 + g) * 33 + 32) * 64 + pp];
    const int len = seq < 2 ? 16384 : 2048;
    const int rb = seq < 2 ? seq * 16384 : 32768 + (seq - 2) * 2048;
    const int n = 2 + len / 32, mc0 = (META0 + 64 * seq) / 32, rc0 = rb / 32;
    float cr = 0.f, ci = 0.f;
    const int col = g * 256 + dir * 128 + pp;
#pragma unroll 1
    for (int b0 = 0; b0 < n; b0 += 8) {
      float sr[8], si[8]; int off[8];
#pragma unroll
      for (int k = 0; k < 8; ++k) {
        int ii = b0 + k; if (ii > n - 1) ii = n - 1;
        const int i = dir == 0 ? ii : n - 1 - ii;
        const int ch = i < 2 ? mc0 + i : rc0 + (i - 2);
        off[k] = ch * 8192 + col;
        sr[k] = Sloc[off[k]]; si[k] = Sloc[off[k] + 64];
      }
#pragma unroll
      for (int k = 0; k < 8; ++k) {
        if (b0 + k < n) {
          carry[off[k]] = f2bf(cr); carry[off[k] + 64] = f2bf(ci);
          const float nr = aT.x * cr - aT.y * ci + sr[k], ni = aT.x * ci + aT.y * cr + si[k];
          cr = nr; ci = ni;
        }
      }
    }
  }
}

DEVI void phase_latent_rstd(const Params& p) {
  char* ar = p.ws + O_ARENA;
  const bf16_t* cq = (const bf16_t*)(ar + A_CQ); const bf16_t* ckv = (const bf16_t*)(ar + A_CKV);
  float* rs = (float*)(p.ws + O_RSTD);
  const int tid = otid(), l32 = tid & 31;
  const int hw = blockIdx.x * 16 + (tid >> 5), nhw = gridDim.x * 16;
  for (int m = hw; m < MPAD; m += nhw) {
    float sq = 0.f, sk = 0.f;
#pragma unroll
    for (int i = 0; i < 3; ++i) { const f32x4 v = unpack4(*(const u32x2*)(cq + (size_t)m * 384 + i * 128 + l32 * 4)); sq += v[0] * v[0] + v[1] * v[1] + v[2] * v[2] + v[3] * v[3]; }
#pragma unroll
    for (int i = 0; i < 2; ++i) { const f32x4 v = unpack4(*(const u32x2*)(ckv + (size_t)m * 256 + i * 128 + l32 * 4)); sk += v[0] * v[0] + v[1] * v[1] + v[2] * v[2] + v[3] * v[3]; }
#pragma unroll
    for (int o = 16; o >= 1; o >>= 1) { sq += __shfl_xor(sq, o); sk += __shfl_xor(sk, o); }
    if (l32 == 0) { rs[m * 2] = rsqrtf(sq * (1.f / 384.f) + 1e-6f); rs[m * 2 + 1] = rsqrtf(sk * (1.f / 256.f) + 1e-6f); }
  }
}

template <int MI, class F>
DEVI void epi_tile(const f32x16 (&acc)[MI][2], char* lds, F f) {
  const int lane = otid() & 63, wid = otid() >> 6, r32 = lane & 31, hi = lane >> 5;
  float* blk = (float*)(lds + wid * 8192);
#pragma unroll
  for (int mi = 0; mi < MI; ++mi) {
#pragma unroll
    for (int ni = 0; ni < 2; ++ni)
#pragma unroll
      for (int r = 0; r < 16; ++r) blk[crow(r, hi) * 64 + ni * 32 + r32] = acc[mi][ni][r];
    asm volatile("s_waitcnt lgkmcnt(0)" ::: "memory");
    __builtin_amdgcn_wave_barrier();
#pragma unroll
    for (int q = 0; q < 8; ++q) {
      const int row = q * 4 + (lane >> 4), col = (lane & 15) * 4;
      const f32x4 v = *(const f32x4*)(blk + row * 64 + col);
      f(mi * 32 + row, col, v);
    }
    asm volatile("s_waitcnt lgkmcnt(0)" ::: "memory");
    __builtin_amdgcn_wave_barrier();
  }
}
template <int MI, class F>
DEVI void epi_tile_pair(const f32x16 (&acc)[MI][2], char* lds, F f) {
  const int lane = otid() & 63, wid = otid() >> 6, r32 = lane & 31, hi = lane >> 5;
  float* blk = (float*)(lds + wid * 8192);
#pragma unroll
  for (int mi = 0; mi < MI; ++mi) {
#pragma unroll
    for (int ni = 0; ni < 2; ++ni)
#pragma unroll
      for (int r = 0; r < 16; ++r) blk[crow(r, hi) * 64 + ni * 32 + r32] = acc[mi][ni][r];
    asm volatile("s_waitcnt lgkmcnt(0)" ::: "memory");
    __builtin_amdgcn_wave_barrier();
#pragma unroll
    for (int q = 0; q < 4; ++q) {
      const int row = q * 8 + (lane >> 3), col = (lane & 7) * 4;
      const f32x4 v1 = *(const f32x4*)(blk + row * 64 + col);
      const f32x4 v2 = *(const f32x4*)(blk + row * 64 + 32 + col);
      f(mi * 32 + row, col, v1, v2);
    }
    asm volatile("s_waitcnt lgkmcnt(0)" ::: "memory");
    __builtin_amdgcn_wave_barrier();
  }
}
DEVI u32x2 pack4(f32x4 v) { u32x2 w; w.x = cvtpk(v[0], v[1]); w.y = cvtpk(v[2], v[3]); return w; }

template <int MI, class PT, class P, class F>
DEVI void epi_tile_pf(const f32x16 (&acc)[MI][2], char* lds, P pre, F f) {
  const int lane = otid() & 63, wid = otid() >> 6, r32 = lane & 31, hi = lane >> 5;
  float* blk = (float*)(lds + wid * 8192);
#pragma unroll
  for (int mi = 0; mi < MI; ++mi) {
    PT pv[8];
#pragma unroll
    for (int q = 0; q < 8; ++q) pv[q] = pre(mi * 32 + q * 4 + (lane >> 4), (lane & 15) * 4);
#pragma unroll
    for (int ni = 0; ni < 2; ++ni)
#pragma unroll
      for (int r = 0; r < 16; ++r) blk[crow(r, hi) * 64 + ni * 32 + r32] = acc[mi][ni][r];
    asm volatile("s_waitcnt lgkmcnt(0)" ::: "memory");
    __builtin_amdgcn_wave_barrier();
#pragma unroll
    for (int q = 0; q < 8; ++q) {
      const int row = q * 4 + (lane >> 4), col = (lane & 15) * 4;
      const f32x4 v = *(const f32x4*)(blk + row * 64 + col);
      f(mi * 32 + row, col, v, pv[q]);
    }
    asm volatile("s_waitcnt lgkmcnt(0)" ::: "memory");
    __builtin_amdgcn_wave_barrier();
  }
}
DEVI void phase_proj(const Params& p, char* lds) {
  char* ar = p.ws + O_ARENA;
  const bf16_t* xn = (const bf16_t*)(ar + A_XN1); const bf16_t* W = (const bf16_t*)(p.ws + O_WIN);
  bf16_t* u = (bf16_t*)(ar + A_U); bf16_t* cq = (bf16_t*)(ar + A_CQ); bf16_t* ckv = (bf16_t*)(ar + A_CKV); bf16_t* kr = (bf16_t*)(ar + A_KR);
  const float2* rope = (const float2*)(p.ws + O_ROPE);
  const int wid = otid() >> 6, wm = wid >> 2, wn = wid & 3;
  GStage<2> st;
  int nt, mt; bool have = unit_xcd(0, 390, 5, mt, nt);
  if (have) gemm_prefetch<2>(st, xn + (size_t)mt * 128 * 1024, 1024, 128, 30, 0, W + (size_t)nt * 256 * 1024, 1024, 1024);
  for (int ui = 0; have; ++ui) {
    f32x16 acc[2][2]; zero_acc<2>(acc);
    gemm_main<2, 1, 4>(acc, st, xn + (size_t)mt * 128 * 1024, 1024, 128, 30, 0, W + (size_t)nt * 256 * 1024, 1024, 1024, lds);
    int nt2, mt2; const bool hn = unit_xcd(ui + 1, 390, 5, mt2, nt2);
    if (hn) gemm_prefetch<2>(st, xn + (size_t)mt2 * 128 * 1024, 1024, 128, 30, 0, W + (size_t)nt2 * 256 * 1024, 1024, 1024);
    const int nb = nt * 256 + wn * 64, m0 = mt * 128 + wm * 64;
    if (nb < 1152) {
      bf16_t* dst; int ld, c0;
      if (nb < 512) { dst = u; ld = 512; c0 = nb; } else if (nb < 896) { dst = cq; ld = 384; c0 = nb - 512; } else { dst = ckv; ld = 256; c0 = nb - 896; }
      dst += (size_t)m0 * ld + c0;
      epi_tile<2>(acc, lds, [&](int row, int col, f32x4 v) { *(u32x2*)(dst + row * ld + col) = pack4(v); });
    } else if (nb == 1152) {
      bf16_t* dst = kr + (size_t)m0 * 64;
      epi_tile_pair<2>(acc, lds, [&](int row, int col, f32x4 x1, f32x4 x2) {
        const float2* cs = rope + pos_of_row(m0 + row) * 32 + col;
        f32x4 o1, o2;
#pragma unroll
        for (int e = 0; e < 4; ++e) { const float2 c = cs[e]; o1[e] = x1[e] * c.x - x2[e] * c.y; o2[e] = x1[e] * c.y + x2[e] * c.x; }
        *(u32x2*)(dst + row * 64 + col) = pack4(o1); *(u32x2*)(dst + row * 64 + 32 + col) = pack4(o2);
      });
    }
    mt = mt2; nt = nt2; have = hn;
  }
}

DEVI void phase_s5a1(const Params& p, char* lds) {
  char* ar = p.ws + O_ARENA;
  const bf16_t* u = (const bf16_t*)(ar + A_U); const bf16_t* W1T = (const bf16_t*)(p.ws + O_W1T); float* Sloc = (float*)(ar + A_SLOC);
  const int wid = otid() >> 6, wm = wid >> 2, wn = wid & 3;
  for (int un = blockIdx.x; un < 13 * 32; un += gridDim.x) {
    const int g = un & 31, rt = un >> 5;
    f32x16 acc[2][2]; zero_acc<2>(acc);
    gemm_acc<2>(acc, u + (size_t)rt * 128 * 16384 + g * 16, 16384, NCHUNK - rt * 128, 4, 512, W1T + (size_t)g * 256 * 512, 512, 512, lds);
    float* dst = Sloc + ((size_t)(rt * 128 + wm * 64) * 32 + g) * 256 + wn * 64;
    epi_tile<2>(acc, lds, [&](int row, int col, f32x4 v) { *(f32x4*)(dst + row * 8192 + col) = v; });
  }
}

DEVI void phase_s5a3(const Params& p, char* lds) {
  char* ar = p.ws + O_ARENA;
  const bf16_t* u = (const bf16_t*)(ar + A_U); const bf16_t* carry = (const bf16_t*)(ar + A_CARRY);
  const bf16_t* W3T = (const bf16_t*)(p.ws + O_W3T); bf16_t* z1 = (bf16_t*)(ar + A_Z1);
  const int wid = otid() >> 6, wm = wid >> 2, wn = wid & 3;
  for (int un = blockIdx.x; un < 13 * 32 * 2; un += gridDim.x) {
    const int nt = un & 1, g = (un >> 1) & 31, rt = un >> 6;
    f32x16 acc[2][2]; zero_acc<2>(acc);
    const bf16_t* Bt = W3T + (size_t)(g * 512 + nt * 256) * 768;
    gemm_acc<2>(acc, u + (size_t)rt * 128 * 16384 + g * 16, 16384, NCHUNK - rt * 128, 4, 512, Bt, 768, 512, lds);
    gemm_acc<2>(acc, carry + (size_t)rt * 128 * 8192 + g * 256, 8192, 128, 30, 0, Bt + 512, 768, 256, lds);
    const int c0 = rt * 128 + wm * 64, nb = nt * 256 + wn * 64;
    bf16_t* dst = z1 + (size_t)c0 * 16384 + g * 16;
    epi_tile<2>(acc, lds, [&](int row, int col, f32x4 v) {
      if (c0 + row < NCHUNK) {
        const int n = nb + col, j = n >> 4, h = n & 15;
        f32x4 o;
#pragma unroll
        for (int e = 0; e < 4; ++e) { const float y = v[e]; const float t = 1.5957691216057308f * (y + 0.044715f * y * y * y); o[e] = y * sigmoidf_(t); }
        *(u32x2*)(dst + row * 16384 + j * 512 + h) = pack4(o);
      }
    });
  }
}

DEVI void phase_glu(const Params& p, int L, char* lds) {
  char* ar = p.ws + O_ARENA;
  const bf16_t* z1 = (const bf16_t*)(ar + A_Z1); const bf16_t* W = (const bf16_t*)(p.ws + O_WGLU); bf16_t* z2 = (bf16_t*)(ar + A_Z2);
  const float* bg = p.b_glu + L * 512;
  const int wid = otid() >> 6, wm = wid >> 2, wn = wid & 3;
  for (int ui = 0;; ++ui) {
    int nt, mt; if (!unit_xcd(ui, 390, 2, mt, nt)) break;
    f32x16 acc[2][2]; zero_acc<2>(acc);
    gemm_acc<2>(acc, z1 + (size_t)mt * 128 * 512, 512, 128, 30, 0, W + (size_t)nt * 256 * 512, 512, 512, lds);
    const int nb = nt * 256 + wn * 64, m0 = mt * 128 + wm * 64;
    const bf16_t* src = z1 + (size_t)m0 * 512 + nb; bf16_t* dst = z2 + (size_t)m0 * 512 + nb; const float* bb = bg + nb;
    epi_tile_pf<2, u32x2>(acc, lds, [&](int row, int col) { return *(const u32x2*)(src + row * 512 + col); },
                          [&](int row, int col, f32x4 v, u32x2 zz) {
      const f32x4 z = unpack4(zz);
      const f32x4 b = *(const f32x4*)(bb + col);
      f32x4 o;
#pragma unroll
      for (int e = 0; e < 4; ++e) o[e] = z[e] * sigmoidf_(v[e] + b[e]);
      *(u32x2*)(dst + row * 512 + col) = pack4(o);
    });
  }
}

DEVI void phase_qkv(const Params& p, int grp, char* lds) {
  char* ar = p.ws + O_ARENA;
  const bf16_t* cq = (const bf16_t*)(ar + A_CQ); const bf16_t* ckv = (const bf16_t*)(ar + A_CKV);
  bf16_t* qg = (bf16_t*)(ar + A_QG); bf16_t* kvg = (bf16_t*)(ar + A_KVG);
  const bf16_t* Wq = (const bf16_t*)(p.ws + O_WUQ); const bf16_t* Wkv = (const bf16_t*)(p.ws + O_WUKV);
  const float2* rope = (const float2*)(p.ws + O_ROPE);
  float* rstd_l = (float*)(lds + 131072);
  const int tid = otid(), wid = tid >> 6, wm = wid >> 2, wn = wid & 3;
  const int greal0 = grp * 16384, seq0 = grp < 2 ? grp : 2;
#define QKV_UNIT(un_, iskv_, nt_, lt_, gb_, arows_, KL_, A_, B_)                                                        \
  const bool iskv_ = (un_) < 132 * 8; const int v_##un_ = iskv_ ? (un_) : (un_) - 132 * 8;                              \
  const int nt_ = iskv_ ? (v_##un_ & 7) : (v_##un_ % 6), lt_ = iskv_ ? (v_##un_ >> 3) : (v_##un_ / 6);                  \
  const int gb_ = lt_ < 128 ? greal0 + lt_ * 128 : META0 + 64 * seq0 + (lt_ - 128) * 128;                              \
  const int arows_ = MPAD - gb_; const int KL_ = iskv_ ? 256 : 384;                                                     \
  const bf16_t* A_ = (iskv_ ? ckv : cq) + (size_t)gb_ * KL_;                                                            \
  const bf16_t* B_ = (iskv_ ? Wkv : Wq) + (size_t)nt_ * 256 * KL_;
  GStage<2> st;
  if ((int)blockIdx.x < 132 * 14) {
    const int u0 = blockIdx.x;
    QKV_UNIT(u0, k0_, n0_, l0_, g0_, r0_, K0_, A0_, B0_)
    (void)n0_; (void)l0_;
    gemm_prefetch<2>(st, A0_, K0_, r0_, 30, 0, B0_, K0_, K0_);
  }
  for (int un = blockIdx.x; un < 132 * 14; un += gridDim.x) {
    QKV_UNIT(un, iskv, nt, lt, gb, arows, KL, A, Bw)
    if (tid < 128) { int gr = gb + tid; if (gr > MPAD - 1) gr = MPAD - 1; rstd_l[tid] = ((const float*)(p.ws + O_RSTD))[gr * 2 + (iskv ? 1 : 0)]; }
    f32x16 acc[2][2]; zero_acc<2>(acc);
    gemm_main<2, 1, 4>(acc, st, A, KL, arows, 30, 0, Bw, KL, KL, lds);
    const int un2 = un + gridDim.x;
    if (un2 < 132 * 14) {
      QKV_UNIT(un2, k2_, n2_, l2_, g2_, r2_, K2_, A2_, B2_)
      (void)n2_; (void)l2_;
      gemm_prefetch<2>(st, A2_, K2_, r2_, 30, 0, B2_, K2_, K2_);
    }
    const int nb = nt * 256 + wn * 64, ml0 = wm * 64;
    const bool ropeslab = !iskv && ((nb >> 6) % 3) == 2;
    if (!ropeslab) {
      const int ld = iskv ? 2048 : 1536;
      bf16_t* dst = (iskv ? kvg : qg) + (size_t)(lt * 128 + ml0) * ld + nb;
      epi_tile<2>(acc, lds, [&](int row, int col, f32x4 vv) {
        const float rs = rstd_l[ml0 + row];
        *(u32x2*)(dst + row * ld + col) = pack4(vv * rs);
      });
    } else {
      bf16_t* dst = qg + (size_t)(lt * 128 + ml0) * 1536 + nb;
      epi_tile_pair<2>(acc, lds, [&](int row, int col, f32x4 x1, f32x4 x2) {
        int gm = gb + ml0 + row; if (gm >= MPAD) gm = MPAD - 1;
        const float2* cs = rope + pos_of_row(gm) * 32 + col;
        const float rs = rstd_l[ml0 + row];
        f32x4 o1, o2;
#pragma unroll
        for (int e = 0; e < 4; ++e) { const float2 c = cs[e]; const float a = x1[e] * rs, b = x2[e] * rs; o1[e] = a * c.x - b * c.y; o2[e] = a * c.y + b * c.x; }
        *(u32x2*)(dst + row * 1536 + col) = pack4(o1); *(u32x2*)(dst + row * 1536 + 32 + col) = pack4(o2);
      });
    }
    __syncthreads();
  }
#undef QKV_UNIT
}

DEVI void phase_merge(const Params& p, char* lds) {
  constexpr int MIV = 2;
  char* ar = p.ws + O_ARENA;
  const bf16_t* xn = (const bf16_t*)(ar + A_XN2); const bf16_t* z2 = (const bf16_t*)(ar + A_Z2); const bf16_t* o = (const bf16_t*)(ar + A_O);
  bf16_t* mg = (bf16_t*)(ar + A_MERGED);
  const bf16_t* Wg = (const bf16_t*)(p.ws + O_WG); const bf16_t* Wssm = (const bf16_t*)(p.ws + O_WSSM); const bf16_t* Wattn = (const bf16_t*)(p.ws + O_WATTN);
  const int wid = otid() >> 6, wm = wid >> 2, wn = wid & 3;
  GStage<2> st;
  int nt, mt; bool have = unit_xcd(0, 390, 4, mt, nt);
  if (have) gemm_prefetch<2>(st, xn + (size_t)mt * 128 * 1024, 1024, 128, 30, 0, Wg + (size_t)(nt * 256) * 1024, 1024, 1024);
  for (int ui = 0; have; ++ui) {
    const int nb = nt * 256 + wn * 64, m0 = mt * 128 + wm * 64;
    bf16_t* dst = mg + (size_t)m0 * 1024 + nb;
    unsigned spk[2][2][8];
    f32x16 acc[2][2];
    zero_acc<2>(acc);
    gemm_main<2>(acc, st, xn + (size_t)mt * 128 * 1024, 1024, 128, 30, 0, Wg + (size_t)(nt * 256) * 1024, 1024, 1024, lds);
    gemm_prefetch<2>(st, z2 + (size_t)mt * 128 * 512, 512, 128, 30, 0, Wssm + (size_t)(nt * 256) * 512, 512, 512);
    FOR_MN(mi, ni) {
#pragma unroll
      for (int q = 0; q < 8; ++q) spk[mi][ni][q] = cvtpk(sigmoidf_(acc[mi][ni][2 * q]), sigmoidf_(acc[mi][ni][2 * q + 1]));
    }
    zero_acc<2>(acc);
    gemm_main<2>(acc, st, z2 + (size_t)mt * 128 * 512, 512, 128, 30, 0, Wssm + (size_t)(nt * 256) * 512, 512, 512, lds);
    gemm_prefetch<2>(st, xn + (size_t)mt * 128 * 1024, 1024, 128, 30, 0, Wg + (size_t)(1024 + nt * 256) * 1024, 1024, 1024);
    FOR_MN(mi, ni) {
#pragma unroll
      for (int q = 0; q < 8; ++q) {
        const unsigned w = spk[mi][ni][q];
        acc[mi][ni][2 * q] *= __uint_as_float(w << 16); acc[mi][ni][2 * q + 1] *= __uint_as_float(w & 0xffff0000u);
      }
    }
    epi_tile<2>(acc, lds, [&](int row, int col, f32x4 v) { *(u32x2*)(dst + row * 1024 + col) = pack4(v); });
    zero_acc<2>(acc);
    gemm_main<2>(acc, st, xn + (size_t)mt * 128 * 1024, 1024, 128, 30, 0, Wg + (size_t)(1024 + nt * 256) * 1024, 1024, 1024, lds);
    gemm_prefetch<2>(st, o + (size_t)mt * 128 * 1024, 1024, 128, 30, 0, Wattn + (size_t)(nt * 256) * 1024, 1024, 1024);
    FOR_MN(mi, ni) {
#pragma unroll
      for (int q = 0; q < 8; ++q) spk[mi][ni][q] = cvtpk(sigmoidf_(acc[mi][ni][2 * q]), sigmoidf_(acc[mi][ni][2 * q + 1]));
    }
    zero_acc<2>(acc);
    gemm_main<2>(acc, st, o + (size_t)mt * 128 * 1024, 1024, 128, 30, 0, Wattn + (size_t)(nt * 256) * 1024, 1024, 1024, lds);
    int nt2, mt2; const bool hn = unit_xcd(ui + 1, 390, 4, mt2, nt2);
    if (hn) gemm_prefetch<2>(st, xn + (size_t)mt2 * 128 * 1024, 1024, 128, 30, 0, Wg + (size_t)(nt2 * 256) * 1024, 1024, 1024);
    FOR_MN(mi, ni) {
#pragma unroll
      for (int q = 0; q < 8; ++q) {
        const unsigned w = spk[mi][ni][q];
        acc[mi][ni][2 * q] *= __uint_as_float(w << 16); acc[mi][ni][2 * q + 1] *= __uint_as_float(w & 0xffff0000u);
      }
    }
    epi_tile_pf<2, u32x2>(acc, lds, [&](int row, int col) { return *(const u32x2*)(dst + row * 1024 + col); },
                          [&](int row, int col, f32x4 v, u32x2 mm) { *(u32x2*)(dst + row * 1024 + col) = pack4(unpack4(mm) + v); });
    mt = mt2; nt = nt2; have = hn;
  }
}

DEVI void phase_resid_gemm(const Params& p, const bf16_t* __restrict__ A, int K, const bf16_t* __restrict__ Bt, bool layer0_resid, char* lds) {
  const int wid = otid() >> 6, wm = wid >> 2, wn = wid & 3;
  GStage<2> st;
  int nt, mt; bool have = unit_xcd(0, 390, 4, mt, nt);
  if (have) gemm_prefetch<2>(st, A + (size_t)mt * 128 * K, K, 128, 30, 0, Bt + (size_t)(nt * 256) * K, K, K);
  for (int ui = 0; have; ++ui) {
    f32x16 acc[2][2]; zero_acc<2>(acc);
    gemm_main<2, 1, 4>(acc, st, A + (size_t)mt * 128 * K, K, 128, 30, 0, Bt + (size_t)(nt * 256) * K, K, K, lds);
    int nt2, mt2; const bool hn = unit_xcd(ui + 1, 390, 4, mt2, nt2);
    if (hn) gemm_prefetch<2>(st, A + (size_t)mt2 * 128 * K, K, 128, 30, 0, Bt + (size_t)(nt2 * 256) * K, K, K);
    float* hb = mt < 384 ? p.out + (size_t)mt * 128 * 1024 : (float*)(p.ws + O_HMETA) + (size_t)(mt - 384) * 128 * 1024;
    const float* rb = hb;
    if (layer0_resid && mt < 384) rb = mt < 256 ? p.x_prompt + (size_t)mt * 128 * 1024 : p.x_sample + (size_t)(mt - 256) * 128 * 1024;
    const int nb = nt * 256 + wn * 64, ml0 = wm * 64;
    hb += ml0 * 1024 + nb; rb += ml0 * 1024 + nb;
    const int lr0 = mt >= 384 ? (mt - 384) * 128 + ml0 : -1;
    epi_tile_pf<2, f32x4>(acc, lds, [&](int row, int col) { return *(const f32x4*)(rb + row * 1024 + col); },
                          [&](int row, int col, f32x4 v, f32x4 res) {
      f32x4 r = res + v;
      if (lr0 >= 0 && is_pad_lr(lr0 + row)) r = (f32x4){0.f, 0.f, 0.f, 0.f};
      *(f32x4*)(hb + row * 1024 + col) = r;
    });
    mt = mt2; nt = nt2; have = hn;
  }
}

DEVI void phase_ffn_up(const Params& p, char* lds) {
  char* ar = p.ws + O_ARENA;
  const bf16_t* xn = (const bf16_t*)(ar + A_XN3); const bf16_t* W = (const bf16_t*)(p.ws + O_WGU); bf16_t* hid = (bf16_t*)(ar + A_HID);
  const int wid = otid() >> 6, wm = wid >> 2, wn = wid & 3;
  for (int ui = 0;; ++ui) {
    int nt, mt; if (!unit_xcd_cb(ui, 195, 22, 4, mt, nt)) break;
    f32x16 acc[4][2]; zero_acc<4>(acc);
    gemm_acc<4, 1>(acc, xn + (size_t)mt * 256 * LDX, LDX, 256, 30, 0, W + (size_t)(nt * 256) * LDX, LDX, 1024, lds);
    bf16_t* dst = hid + (size_t)(mt * 256 + wm * 128) * 2816 + (nt * 4 + wn) * 32;
    epi_tile_pair<4>(acc, lds, [&](int row, int col, f32x4 g, f32x4 uu) {
      f32x4 o;
#pragma unroll
      for (int e = 0; e < 4; ++e) o[e] = g[e] * sigmoidf_(g[e]) * uu[e];
      *(u32x2*)(dst + row * 2816 + col) = pack4(o);
    });
  }
}

constexpr float ATT_SCALE = 0.07216878364870322f;
constexpr float ATT_THR = 8.f;
#define KSWZ(row, colB) ((row) * 256 + ((colB) ^ (((row) & 15) << 4)))

DEVI void partialSM(f32x16& p0, f32x16& p1, float& m_reg, float& mn, float& alpha) {
  constexpr float C = ATT_SCALE * 1.4426950408889634f;
  float pmax = p0[0];
#pragma unroll
  for (int r = 1; r < 16; ++r) pmax = fmaxf(pmax, p0[r]);
#pragma unroll
  for (int r = 0; r < 16; ++r) pmax = fmaxf(pmax, p1[r]);
  { auto rr = __builtin_amdgcn_permlane32_swap(__float_as_uint(pmax), __float_as_uint(pmax), false, false);
    pmax = fmaxf(__uint_as_float(rr[0]), __uint_as_float(rr[1])); }
  if (__builtin_expect(__all(pmax - m_reg <= ATT_THR / ATT_SCALE), 1)) { mn = m_reg; alpha = 1.f; }
  else { mn = fmaxf(m_reg, pmax); alpha = __builtin_amdgcn_exp2f((m_reg - mn) * C); m_reg = mn; }
  const float mnC = -mn * C;
#pragma unroll
  for (int r = 0; r < 16; ++r) p0[r] = fmaf(p0[r], C, mnC);
#pragma unroll
  for (int r = 0; r < 16; ++r) p1[r] = fmaf(p1[r], C, mnC);
#pragma unroll
  for (int r = 0; r < 16; ++r) p0[r] = __builtin_amdgcn_exp2f(p0[r]);
}
DEVI void finishSM(f32x16& p0, f32x16& p1, float alpha, float& l_reg, bf16x8& pa0, bf16x8& pa1, bf16x8& pa2, bf16x8& pa3) {
#pragma unroll
  for (int r = 0; r < 16; ++r) p1[r] = __builtin_amdgcn_exp2f(p1[r]);
  float ps = 0;
#pragma unroll
  for (int r = 0; r < 16; ++r) ps += p0[r];
#pragma unroll
  for (int r = 0; r < 16; ++r) ps += p1[r];
  { auto rr = __builtin_amdgcn_permlane32_swap(__float_as_uint(ps), __float_as_uint(ps), false, false);
    ps = __uint_as_float(rr[0]) + __uint_as_float(rr[1]); }
  l_reg = l_reg * alpha + ps;
#define PK4(P, BASE, OUT) do { unsigned a0 = cvtpk(P[BASE + 0], P[BASE + 1]), a1 = cvtpk(P[BASE + 2], P[BASE + 3]);   \
    unsigned b0 = cvtpk(P[BASE + 4], P[BASE + 5]), b1 = cvtpk(P[BASE + 6], P[BASE + 7]);                              \
    auto r0 = __builtin_amdgcn_permlane32_swap(a0, b0, false, false); auto r1 = __builtin_amdgcn_permlane32_swap(a1, b1, false, false); \
    u32x4 w = {r0[0], r1[0], r0[1], r1[1]}; OUT = *reinterpret_cast<bf16x8*>(&w); } while (0)
  PK4(p0, 0, pa0); PK4(p0, 8, pa1); PK4(p1, 0, pa2); PK4(p1, 8, pa3);
#undef PK4
}
DEVI void qkt(f32x16& p0, f32x16& p1, const char* Kn, const char* Kr, const bf16x8* qr, const char* qrl, int r32, int hi) {
#pragma unroll
  for (int r = 0; r < 16; ++r) { p0[r] = 0.f; p1[r] = 0.f; }
#pragma unroll
  for (int d0 = 0; d0 < 8; ++d0) { const int cb = (d0 * 16 + hi * 8) * 2;
    const bf16x8 b0 = *reinterpret_cast<const bf16x8*>(Kn + KSWZ(r32, cb));
    const bf16x8 b1 = *reinterpret_cast<const bf16x8*>(Kn + KSWZ(32 + r32, cb));
    bf16x8 qv;
    if (d0 < 4) qv = qr[d0]; else qv = *reinterpret_cast<const bf16x8*>(qrl + (d0 - 4) * 1024);
    p0 = __builtin_amdgcn_mfma_f32_32x32x16_bf16(b0, qv, p0, 0, 0, 0);
    p1 = __builtin_amdgcn_mfma_f32_32x32x16_bf16(b1, qv, p1, 0, 0, 0); }
  const int swz = (r32 >> 1) & 7;
#pragma unroll
  for (int d0 = 0; d0 < 4; ++d0) { const int so = ((d0 * 2 + hi) ^ swz) << 4;
    const bf16x8 b0 = *reinterpret_cast<const bf16x8*>(Kr + r32 * 128 + so);
    const bf16x8 b1 = *reinterpret_cast<const bf16x8*>(Kr + (32 + r32) * 128 + so);
    const bf16x8 qv = *reinterpret_cast<const bf16x8*>(qrl + (4 + d0) * 1024);
    p0 = __builtin_amdgcn_mfma_f32_32x32x16_bf16(b0, qv, p0, 0, 0, 0);
    p1 = __builtin_amdgcn_mfma_f32_32x32x16_bf16(b1, qv, p1, 0, 0, 0); }
}
DEVI int v_st(int k, int c) { const int kk = (k & ~0xC) | ((k & 4) << 1) | ((k & 8) >> 1); return ((kk >> 3) * 4 + (c >> 5)) * 512 + ((kk & 7) * 32 + (c & 31)) * 2; }
DEVI int v_rd_base(int lane) { return ((lane & 3) << 3) | (((lane >> 2) & 3) << 6) | (((lane >> 4) & 1) << 5) | (((lane >> 5) & 1) << 8); }
constexpr int v_rd_off(int d0, int ks, int half) { return d0 * 512 + ks * 4096 + half * 2048; }
template <int OFF> DEVI s16x4 tr_read(int vb) {
  s16x4 r; asm volatile("ds_read_b64_tr_b16 %0, %1 offset:%2" : "=&v"(r) : "v"(vb), "i"(OFF) : "memory"); return r;
}
template <int D0> DEVI void pv_one(f32x16& od, int vb, bf16x8 pa0, bf16x8 pa1, bf16x8 pa2, bf16x8 pa3) {
  const s16x4 l0 = tr_read<v_rd_off(D0, 0, 0)>(vb), h0 = tr_read<v_rd_off(D0, 0, 1)>(vb), l1 = tr_read<v_rd_off(D0, 1, 0)>(vb), h1 = tr_read<v_rd_off(D0, 1, 1)>(vb);
  const s16x4 l2 = tr_read<v_rd_off(D0, 2, 0)>(vb), h2 = tr_read<v_rd_off(D0, 2, 1)>(vb), l3 = tr_read<v_rd_off(D0, 3, 0)>(vb), h3 = tr_read<v_rd_off(D0, 3, 1)>(vb);
  asm volatile("s_waitcnt lgkmcnt(0)" ::: "memory"); SBAR();
#define PK(L, H) (bf16x8){L[0], L[1], L[2], L[3], H[0], H[1], H[2], H[3]}
  od = __builtin_amdgcn_mfma_f32_32x32x16_bf16(pa0, PK(l0, h0), od, 0, 0, 0);
  od = __builtin_amdgcn_mfma_f32_32x32x16_bf16(pa1, PK(l1, h1), od, 0, 0, 0);
  od = __builtin_amdgcn_mfma_f32_32x32x16_bf16(pa2, PK(l2, h2), od, 0, 0, 0);
  od = __builtin_amdgcn_mfma_f32_32x32x16_bf16(pa3, PK(l3, h3), od, 0, 0, 0);
#undef PK
}
DEVI void pv_d0(f32x16* o, int vb, bf16x8 pa0, bf16x8 pa1, bf16x8 pa2, bf16x8 pa3) {
  pv_one<0>(o[0], vb, pa0, pa1, pa2, pa3); pv_one<1>(o[1], vb, pa0, pa1, pa2, pa3); pv_one<2>(o[2], vb, pa0, pa1, pa2, pa3); pv_one<3>(o[3], vb, pa0, pa1, pa2, pa3);
}

DEVI void attn_unit(const bf16_t* __restrict__ Qg, const bf16_t* __restrict__ KVg, const bf16_t* __restrict__ KR, bf16_t* __restrict__ O,
                    int qrow0, int vlo, int vhi, int orow0, int lmeta, int lreal, int gmeta, int greal, int head, int t0, int NT, float* __restrict__ part, char* lds) {
  const int tid = otid(), wid = tid >> 6, lane = tid & 63, r32 = lane & 31, hi = lane >> 5;
  char* V_lds = lds; char* Kn_lds = lds + 32768; char* Kr_lds = lds + 65536;
  float* wsf = (float*)(lds + 81920) + wid * 64; float* li_l = wsf; float* al_l = wsf + 32;
  float m_reg = -1e30f, l_reg = 0; f32x16 o[4]; bf16x8 qr[4];
  char* qrl = lds + 83968 + wid * 8192 + lane * 16;
#pragma unroll
  for (int d = 0; d < 4; ++d)
#pragma unroll
    for (int r = 0; r < 16; ++r) o[d][r] = 0.f;
  { int qrow = qrow0 + wid * 32 + r32; if (qrow > QG_ROWS - 1) qrow = QG_ROWS - 1;
    const bf16_t* Qw = Qg + (size_t)qrow * 1536 + head * 192 + hi * 8;
#pragma unroll
    for (int d0 = 0; d0 < 4; ++d0) qr[d0] = *reinterpret_cast<const bf16x8*>(Qw + d0 * 16);
#pragma unroll
    for (int d0 = 0; d0 < 8; ++d0) *reinterpret_cast<bf16x8*>(qrl + d0 * 1024) = *reinterpret_cast<const bf16x8*>(Qw + (4 + d0) * 16); }
  const int sr = tid >> 4, sc = (tid & 15) * 8, vst0 = v_st(sr, sc), vst1 = v_st(32 + sr, sc);
  const int krow = tid >> 3, kslot = tid & 7, krofs = krow * 128 + ((kslot ^ ((krow >> 1) & 7)) << 4);
  const int vb0 = (int)(uintptr_t)V_lds + v_rd_base(lane);
  bf16x8 vs0, vs1, ks0, ks1, rs0;
#define SLOAD(j) do { const int jj = t0 + (j); const int lr_ = jj == 0 ? lmeta : lreal + (jj - 1) * 64; const int gr_ = jj == 0 ? gmeta : greal + (jj - 1) * 64; \
    const bf16_t* kvp = KVg + (size_t)(lr_ + sr) * 2048 + head * 256 + sc;                                   \
    ks0 = *reinterpret_cast<const bf16x8*>(kvp); vs0 = *reinterpret_cast<const bf16x8*>(kvp + 128);           \
    ks1 = *reinterpret_cast<const bf16x8*>(kvp + 32 * 2048); vs1 = *reinterpret_cast<const bf16x8*>(kvp + 32 * 2048 + 128); \
    rs0 = *reinterpret_cast<const bf16x8*>(KR + (size_t)(gr_ + krow) * 64 + kslot * 8); } while (0)
#define SWRITE(b) do { *(bf16x8*)(V_lds + (b) * 16384 + vst0) = vs0; *(bf16x8*)(V_lds + (b) * 16384 + vst1) = vs1; const int kc = sc * 2; \
    *(bf16x8*)(Kn_lds + (b) * 16384 + KSWZ(sr, kc)) = ks0; *(bf16x8*)(Kn_lds + (b) * 16384 + KSWZ(32 + sr, kc)) = ks1;    \
    *(bf16x8*)(Kr_lds + (b) * 8192 + krofs) = rs0; } while (0)
#define SWAIT() asm volatile("s_waitcnt vmcnt(0)" ::: "memory")
#define RESC(a) do { if (__any((a) < 1.f)) { if (hi == 0) al_l[r32] = (a); asm volatile("s_waitcnt lgkmcnt(0)" ::: "memory"); \
    _Pragma("unroll") for (int d = 0; d < 4; ++d) _Pragma("unroll") for (int r = 0; r < 16; ++r) o[d][r] *= al_l[crow(r, hi)]; } } while (0)
  f32x16 pA0, pA1, pB0, pB1; float mnA, mnB, alA, alB; bf16x8 pa0, pa1, pa2, pa3;
  SLOAD(0); SWAIT(); SWRITE(0); __syncthreads();
  qkt(pA0, pA1, Kn_lds, Kr_lds, qr, qrl, r32, hi);
  if (t0 == 0) {
#pragma unroll
    for (int r = 0; r < 16; ++r) pA0[r] = -1e30f;
#pragma unroll
    for (int r = 0; r < 8; ++r) pA1[r] = -1e30f;
  }
  partialSM(pA0, pA1, m_reg, mnA, alA);
  if (NT > 1) { SLOAD(1); SWAIT(); SWRITE(1); }
  __syncthreads();
  for (int j = 1; j + 1 < NT; j += 2) {
    SBAR(); qkt(pB0, pB1, Kn_lds + 16384, Kr_lds + 8192, qr, qrl, r32, hi);
    finishSM(pA0, pA1, alA, l_reg, pa0, pa1, pa2, pa3); SBAR();
    SLOAD(j + 1); SBAR();
    pv_d0(o, vb0, pa0, pa1, pa2, pa3); partialSM(pB0, pB1, m_reg, mnB, alB);
    __syncthreads(); SWAIT(); SWRITE(0);
    RESC(alB); __syncthreads();
    SBAR(); qkt(pA0, pA1, Kn_lds, Kr_lds, qr, qrl, r32, hi);
    finishSM(pB0, pB1, alB, l_reg, pa0, pa1, pa2, pa3); SBAR();
    if (j + 2 < NT) SLOAD(j + 2); SBAR();
    pv_d0(o, vb0 + 16384, pa0, pa1, pa2, pa3); partialSM(pA0, pA1, m_reg, mnA, alA);
    __syncthreads(); SWAIT(); SWRITE(1);
    RESC(alA); __syncthreads();
  }
  if ((NT & 1) == 0) {
    SBAR(); qkt(pB0, pB1, Kn_lds + 16384, Kr_lds + 8192, qr, qrl, r32, hi);
    finishSM(pA0, pA1, alA, l_reg, pa0, pa1, pa2, pa3); SBAR();
    pv_d0(o, vb0, pa0, pa1, pa2, pa3); partialSM(pB0, pB1, m_reg, mnB, alB);
    __syncthreads(); RESC(alB);
    finishSM(pB0, pB1, alB, l_reg, pa0, pa1, pa2, pa3); SBAR();
    pv_d0(o, vb0 + 16384, pa0, pa1, pa2, pa3);
  } else {
    finishSM(pA0, pA1, alA, l_reg, pa0, pa1, pa2, pa3); SBAR();
    pv_d0(o, vb0, pa0, pa1, pa2, pa3);
  }
  if (part) {
    if (wid == 1) {
      if (hi == 0 && r32 >= 16) { part[2048 + r32 - 16] = m_reg; part[2064 + r32 - 16] = l_reg; }
#pragma unroll
      for (int r = 8; r < 16; ++r) {
        float* pw = part + (crow(r, hi) - 16) * 128 + r32;
#pragma unroll
        for (int d0 = 0; d0 < 4; ++d0) pw[d0 * 32] = o[d0][r];
      }
    }
  } else {
  if (hi == 0) li_l[r32] = l_reg; asm volatile("s_waitcnt lgkmcnt(0)" ::: "memory");
  float rli[16];
#pragma unroll
  for (int r = 0; r < 16; ++r) rli[r] = __builtin_amdgcn_rcpf(li_l[crow(r, hi)]);
#pragma unroll
  for (int r = 0; r < 16; ++r) {
    const int rb = wid * 32 + crow(r, hi);
    if (rb >= vlo && rb < vhi) {
      bf16_t* Ow = O + (size_t)(orow0 + rb) * 1024 + head * 128 + r32;
#pragma unroll
      for (int d0 = 0; d0 < 4; ++d0) Ow[d0 * 32] = f2bf(o[d0][r] * rli[r]);
    }
  }
  }
#undef SLOAD
#undef SWRITE
#undef SWAIT
#undef RESC
}

constexpr size_t A_PART = 344752128;
constexpr int PART_STRIDE = 16 * 128 + 32;
DEVI void phase_attn(const Params& p, int grp, char* lds) {
  char* ar = p.ws + O_ARENA;
  const bf16_t* qg = (const bf16_t*)(ar + A_QG); const bf16_t* kvg = (const bf16_t*)(ar + A_KVG); const bf16_t* kr = (const bf16_t*)(ar + A_KR);
  bf16_t* o = (bf16_t*)(ar + A_O); float* part = (float*)(ar + A_PART);
  const int nseq = grp < 2 ? 1 : 8, S = grp < 2 ? 16384 : 2048, nqb = S / 256;
  const int NS = grp < 2 ? 32 : 4;
  const int NUR = nseq * 8 * nqb, NU = NUR + nseq * 8 * NS, NT = 1 + S / 64;
  for (int un = blockIdx.x; un < NU; un += gridDim.x) {
    __syncthreads();
    if (un < NUR) {
      const int head = un & 7, t = un >> 3, sl = t / nqb, qb = t % nqb;
      const int seq = grp < 2 ? grp : 2 + sl;
      const int lreal = sl * S, lmeta = 16384 + 64 * sl;
      const int greal = grp < 2 ? grp * 16384 : 32768 + sl * 2048, gmeta = META0 + 64 * seq;
      attn_unit(qg, kvg, kr, o, lreal + qb * 256, 0, 256, greal + qb * 256, lmeta, lreal, gmeta, greal, head, 0, NT, nullptr, lds);
    } else {
      const int v = un - NUR, sp = v % NS, hs = v / NS, head = hs & 7, sl = hs >> 3;
      const int seq = grp < 2 ? grp : 2 + sl;
      const int lreal = sl * S, lmeta = 16384 + 64 * sl;
      const int greal = grp < 2 ? grp * 16384 : 32768 + sl * 2048, gmeta = META0 + 64 * seq;
      const int ta = (sp * NT) / NS, tb = ((sp + 1) * NT) / NS;
      const int pu = grp < 2 ? (grp * 8 + head) * 32 + sp : 512 + (sl * 8 + head) * 4 + sp;
      attn_unit(qg, kvg, kr, o, lmeta, 0, 0, gmeta, lmeta, lreal, gmeta, greal, head, ta, tb - ta, part + (size_t)pu * PART_STRIDE, lds);
    }
  }
}

DEVI void phase_attn_combine(const Params& p) {
  char* ar = p.ws + O_ARENA;
  const float* part = (const float*)(ar + A_PART); bf16_t* o = (bf16_t*)(ar + A_O);
  constexpr float C = ATT_SCALE * 1.4426950408889634f;
  const int gtid = blockIdx.x * 512 + otid(), nthr = gridDim.x * 512;
  for (int it = gtid; it < 10 * 8 * 16 * 128; it += nthr) {
    const int col = it & 127, row = (it >> 7) & 15, head = (it >> 11) & 7, seq = it >> 14;
    const int NS = seq < 2 ? 32 : 4;
    const float* pb = part + (size_t)(seq < 2 ? (seq * 8 + head) * 32 : 512 + ((seq - 2) * 8 + head) * 4) * PART_STRIDE;
    float M = -3.0e38f;
    for (int s2 = 0; s2 < NS; ++s2) M = fmaxf(M, pb[(size_t)s2 * PART_STRIDE + 2048 + row]);
    float num = 0.f, den = 0.f;
    for (int s2 = 0; s2 < NS; ++s2) {
      const float* q = pb + (size_t)s2 * PART_STRIDE;
      const float w = __builtin_amdgcn_exp2f((q[2048 + row] - M) * C);
      num += w * q[row * 128 + col]; den += w * q[2064 + row];
    }
    o[(size_t)(META0 + 64 * seq + 48 + row) * 1024 + head * 128 + col] = f2bf(num / den);
  }
}

#define XB_TMO      128
#define XB_XCNT(j)  (256  + 64 * (j))
#define XB_XSUB(j)  (1280 + 64 * (j))
#define XB_XGEN(j)  (2304 + 64 * (j))
#define XB_TOP      3328
#define XB_TOPGEN   3392
#define XCD_BAR_WORDS 3456
#define XB_SPIN_CAP (1u << 18)
#define LAS __attribute__((address_space(3)))

__device__ __forceinline__ unsigned xb_ld(unsigned* p)              { return __hip_atomic_load(p, __ATOMIC_RELAXED, __HIP_MEMORY_SCOPE_AGENT); }
__device__ __forceinline__ unsigned xb_add(unsigned* p, unsigned v) { return __hip_atomic_fetch_add(p, v, __ATOMIC_RELAXED, __HIP_MEMORY_SCOPE_AGENT); }
__device__ __forceinline__ unsigned xb_xcc_id() { return (unsigned)__builtin_amdgcn_s_getreg((3 << 11) | 20) & 0xFu; }
#define XB_SPIN(cond, bar) do { unsigned _sp = 0; while (cond) { __builtin_amdgcn_s_sleep(1); \
    if ((++_sp & 255u) == 0u) { if (xb_ld(&(bar)[XB_TMO])) break; if (_sp > XB_SPIN_CAP) { atomicAdd(&(bar)[XB_TMO], 1u); break; } } } } while (0)

struct XcdBarrier {
    unsigned* bar; unsigned x;
    volatile LAS unsigned* st;
};

__device__ __forceinline__ XcdBarrier xcd_barrier_post(unsigned* bar, volatile LAS unsigned* st) {
    XcdBarrier b; b.bar = bar; b.x = xb_xcc_id(); b.st = st;
    if (__builtin_amdgcn_workitem_id_x() == 0) (void)xb_add(&bar[XB_XCNT(b.x)], 1u);
    return b;
}
__device__ __forceinline__ void xcd_barrier_complete(unsigned* bar, unsigned x, unsigned& nloc, unsigned& nx) {
    const unsigned G = gridDim.x * gridDim.y * gridDim.z;
    unsigned sum, cnt, mine, sp = 0u;
    for (;;) {
        sum = 0u; cnt = 0u; mine = 0u;
#pragma unroll
        for (unsigned j = 0; j < 16; ++j) { const unsigned c = xb_ld(&bar[XB_XCNT(j)]); sum += c; cnt += (c > 0u) ? 1u : 0u; mine = (j == x) ? c : mine; }
        if (sum == G) break;
        __builtin_amdgcn_s_sleep(1);
        if ((++sp & 255u) == 0u) { if (xb_ld(&bar[XB_TMO])) break; if (sp > XB_SPIN_CAP) { atomicAdd(&bar[XB_TMO], 1u); break; } }
    }
    nloc = mine > 0u ? mine : 1u; nx = cnt > 0u ? cnt : 1u;
}

__device__ __forceinline__ void xcd_barrier(const XcdBarrier& b) {
    asm volatile("s_waitcnt vmcnt(0)" ::: "memory");
    __syncthreads();
    if (__builtin_amdgcn_workitem_id_x() == 0) {
        unsigned* bar = b.bar;
        __builtin_amdgcn_s_waitcnt(0);
        unsigned nloc = b.st[0], nx = b.st[1];
        if (nloc == 0u) { xcd_barrier_complete(bar, b.x, nloc, nx); b.st[0] = nloc; b.st[1] = nx; }
        const unsigned old = xb_add(&bar[XB_XSUB(b.x)], 1u);
        const unsigned gen = old / nloc;
        if (old + 1u == (gen + 1u) * nloc) {
            __builtin_amdgcn_fence(__ATOMIC_RELEASE, "agent");
            asm volatile("s_waitcnt vmcnt(0)" ::: "memory");
            const unsigned og = xb_add(&bar[XB_TOP], 1u);
            const unsigned tg = og / nx;
            if (og + 1u == (tg + 1u) * nx) xb_add(&bar[XB_TOPGEN], 1u);
            else XB_SPIN(xb_ld(&bar[XB_TOPGEN]) == tg, bar);
            __builtin_amdgcn_fence(__ATOMIC_ACQUIRE, "agent");
            xb_add(&bar[XB_XGEN(b.x)], 1u);
            asm volatile("s_waitcnt vmcnt(0)" ::: "memory");
        } else {
            XB_SPIN(xb_ld(&bar[XB_XGEN(b.x)]) == gen, bar);
            __builtin_amdgcn_fence(__ATOMIC_ACQUIRE, "agent");
            asm volatile("s_waitcnt vmcnt(0)" ::: "memory");
        }
    }
    __syncthreads();
}


DEVI void run_group(const Params& p, int gi, char* lds) {
  char* ar = p.ws + O_ARENA;
  if (gi == 36) { phase_final_norm(p); return; }
  const int L = gi >= 18 ? 1 : 0, st = gi - 18 * L;
  switch (st) {
    case 0:
      phase_convert(p, L, lds);
      phase_s5prep1(p, L);
      if (L == 0) phase_rope_table(p);
      phase_norm(p, p.norm_mix + L * 1024, (bf16_t*)(ar + A_XN1), L == 0);
      break;
    case 1: phase_s5prep2(p, L); phase_proj(p, lds); break;
    case 2: phase_s5prep3(p, L); phase_latent_rstd(p); phase_s5a1(p, lds); break;
    case 3: phase_carry(p); break;
    case 4: phase_s5a3(p, lds); break;
    case 5: phase_glu(p, L, lds); break;
    case 6: case 8: case 10: phase_qkv(p, (st - 6) >> 1, lds); break;
    case 7: case 9: case 11: phase_attn(p, (st - 7) >> 1, lds); break;
    case 12: phase_attn_combine(p); phase_norm(p, p.norm_mix + L * 1024, (bf16_t*)(ar + A_XN2), L == 0); break;
    case 13: phase_merge(p, lds); break;
    case 14: phase_resid_gemm(p, (const bf16_t*)(ar + A_MERGED), 1024, (const bf16_t*)(p.ws + O_WMIX), L == 0, lds); break;
    case 15: phase_norm(p, p.norm_ffn + L * 1024, (bf16_t*)(ar + A_XN3), false, LDX); break;
    case 16: phase_ffn_up(p, lds); break;
    default: phase_resid_gemm(p, (const bf16_t*)(ar + A_HID), 2816, (const bf16_t*)(p.ws + O_WD), false, lds); break;
  }
}


#ifndef DBG_GROUPS
#define DBG_GROUPS 0
#endif
#ifndef DBG_OFF
#define DBG_OFF 0
#endif
#ifndef DBG_N
#define DBG_N 1
#endif
__global__ __launch_bounds__(512) void dbg_dump_kernel(Params p, size_t off, unsigned n) {
  const bf16_t* b = (const bf16_t*)(p.ws + off);
  for (size_t i = (size_t)blockIdx.x * 512 + threadIdx.x; i < (size_t)NREAL * 1024; i += (size_t)gridDim.x * 512)
    p.out[i] = bf2f(b[(unsigned)i % n]);
}
#ifndef MULTI_LAUNCH
#define MULTI_LAUNCH 0
#endif

__global__ __launch_bounds__(512, 1) void mega_fwd(Params p, int g_begin, int g_end) {
  extern __shared__ __attribute__((aligned(16))) char lds[];
  volatile LAS unsigned* xst = (volatile LAS unsigned*)(LAS char*)(lds + LDS_BYTES - 16);
  if (__builtin_amdgcn_workitem_id_x() == 0) { xst[0] = 0u; xst[1] = 0u; }
  __syncthreads();
  const XcdBarrier xb = xcd_barrier_post((unsigned*)(p.ws + O_BAR), xst);
#pragma unroll 1
  for (int gi = g_begin; gi < g_end; ++gi) {
    run_group(p, gi, lds);
    if (gi + 1 < g_end) {
      if (gi == g_begin) { asm volatile("s_waitcnt vmcnt(0) lgkmcnt(0)" ::: "memory"); cg::this_grid().sync(); }
      else xcd_barrier(xb);
    }
  }
}

extern "C" void kernel_launch(void* const* d_in, const int* in_sizes, int n_in, void* d_out, int out_size, void* d_ws, size_t ws_size,
                              hipStream_t stream) {
  static int grid_blocks = 0;
  if (!grid_blocks) {
    if (ws_size < WS_NEED) { fprintf(stderr, "kernel_launch: workspace too small: %zu < %zu\n", ws_size, (size_t)WS_NEED); return; }
    if (hipFuncSetAttribute((const void*)mega_fwd, hipFuncAttributeMaxDynamicSharedMemorySize, LDS_BYTES) != hipSuccess) {
      fprintf(stderr, "kernel_launch: hipFuncSetAttribute failed\n"); return; }
    int dev = 0, cus = 0, per_cu = 0;
    hipGetDevice(&dev);
    hipDeviceGetAttribute(&cus, hipDeviceAttributeMultiprocessorCount, dev);
    hipOccupancyMaxActiveBlocksPerMultiprocessor(&per_cu, mega_fwd, 512, LDS_BYTES);
    if (per_cu < 1) { fprintf(stderr, "kernel_launch: occupancy query returned %d\n", per_cu); return; }
    grid_blocks = cus;
  }
  Params p{};
  const float** f = (const float**)&p;
  for (int i = 0; i < 27; ++i) f[i] = (const float*)d_in[i];
  p.out = (float*)d_out; p.ws = (char*)d_ws;
  for (int i = 0; i < 32; ++i) { const float pw = (float)pow(10000.0, (double)i / 32.0); p.inv[i] = 1.0f / pw; }
  int gb = 0, ge = 37;
  if (MULTI_LAUNCH) {
    const int ng = DBG_GROUPS > 0 ? DBG_GROUPS : 37;
    for (int g = 0; g < ng; ++g) hipLaunchKernelGGL(mega_fwd, dim3(grid_blocks), dim3(512), LDS_BYTES, stream, p, g, g + 1);
    if (DBG_GROUPS > 0) hipLaunchKernelGGL(dbg_dump_kernel, dim3(2048), dim3(512), 0, stream, p, (size_t)(DBG_OFF), (unsigned)(DBG_N));
    return;
  }
  hipMemsetAsync((char*)d_ws + O_BAR, 0, 4096 * 4, stream);
  void* args[] = {&p, &gb, &ge};
  hipError_t e = hipLaunchCooperativeKernel((const void*)mega_fwd, dim3(grid_blocks), dim3(512), args, LDS_BYTES, stream);
  if (e != hipSuccess) fprintf(stderr, "cooperative launch failed: %s (grid %d)\n", hipGetErrorString(e), grid_blocks);
}
```
